# Optimizing an MI355X kernel written in HIP

```python
import jax, jax.numpy as jnp
from jax import lax
import numpy as np

D_MODEL = 4096
BATCH = 4
SEQ = 2048
DEPTH = 1

GRID_W = 64
CTX_LEN = 256
HEAD_DIM = 128
N_HEADS = D_MODEL // HEAD_DIM
N_KV_HEADS = N_HEADS // 4
GROUP = N_HEADS // N_KV_HEADS
ATT_WIDTH = N_HEADS * HEAD_DIM
KV_WIDTH = N_KV_HEADS * HEAD_DIM
Q_BLOCK = 128
ROPE_THETA = 10000.0
AXIS_DIM = HEAD_DIM // 2
HG_EXPAND = 128
HG_HEADS = D_MODEL // HG_EXPAND
HG_DK = HG_EXPAND
HG_DV = D_MODEL // HG_HEADS
HG_KEY_WIDTH = HG_HEADS * HG_DK
HG_VAL_WIDTH = HG_HEADS * HG_DV
CHUNK = 32
EPS = 1e-6

COL_WIDTHS = (KV_WIDTH, KV_WIDTH,
              HG_VAL_WIDTH, HG_KEY_WIDTH, HG_KEY_WIDTH,
              ATT_WIDTH, ATT_WIDTH,
              HG_KEY_WIDTH, HG_VAL_WIDTH,
              D_MODEL, D_MODEL)
N_CTX_PARTS = 5
N_IN = sum(COL_WIDTHS)

kernel_name = "hybrid_hgrn2_gqa_prefix_dit_block"


def rms_norm(x, w):
    xf = x.astype(jnp.float32)
    y = xf * lax.rsqrt(jnp.mean(xf * xf, axis=-1, keepdims=True) + EPS)
    return (y * w.astype(jnp.float32)).astype(x.dtype)


def modulate(h, shift, scale):
    return h * (1 + scale) + shift


def split_cols(p, n_parts):
    points = np.cumsum(np.array(COL_WIDTHS[:n_parts]))[:-1].tolist()
    return jnp.split(p, points, axis=-1)


def axial_rope_tables(rows):
    row = jnp.repeat(jnp.arange(rows, dtype=jnp.float32), GRID_W)
    col = jnp.tile(jnp.arange(GRID_W, dtype=jnp.float32), rows)
    inv = ROPE_THETA ** (-jnp.arange(0, AXIS_DIM, 2, dtype=jnp.float32) / AXIS_DIM)
    fr = row[:, None] * inv[None]
    fc = col[:, None] * inv[None]
    ang = jnp.concatenate([fr, fr, fc, fc], axis=-1)
    return jnp.cos(ang), jnp.sin(ang)


def apply_rope(x, cos, sin):
    shape = (x.shape[1],) + (1,) * (x.ndim - 3) + (HEAD_DIM,)
    cos = cos.reshape(shape).astype(x.dtype)
    sin = sin.reshape(shape).astype(x.dtype)
    a, b, c, d = jnp.split(x, 4, axis=-1)
    rot = jnp.concatenate([-b, a, -d, c], axis=-1)
    return x * cos + rot * sin


def attend(qb, k, v):
    s = jnp.einsum('bqkgd,bskd->bkgqs', qb, k).astype(jnp.float32) * (HEAD_DIM ** -0.5)
    p = jax.nn.softmax(s, axis=-1).astype(v.dtype)
    return jnp.einsum('bkgqs,bskd->bqkgd', p, v)


def block_attention(q, k, v):
    B, T = q.shape[:2]
    qb = jnp.moveaxis(q.reshape(B, T // Q_BLOCK, Q_BLOCK, N_KV_HEADS, GROUP, HEAD_DIM), 1, 0)
    o = lax.map(lambda blk: attend(blk, k, v), qb)
    return jnp.moveaxis(o, 0, 1).reshape(B, T, ATT_WIDTH)


def hg_heads(a, d):
    return a.astype(jnp.float32).reshape(a.shape[:-1] + (HG_HEADS, d))


def hgrn_forget(z, lb):
    f = lb + (1.0 - lb) * jax.nn.sigmoid(z)
    return 1.0 - f, jnp.log(f)


def gla_chunked(q, k, v, g, s0):
    B, T, H, _ = k.shape
    n = T // CHUNK

    def chunks(a):
        return a.reshape(B, n, CHUNK, H, a.shape[-1])

    k, v, g = chunks(k), chunks(v), chunks(g)
    b = jnp.cumsum(g, axis=2)
    b_last = b[:, :, -1:]
    kd = k * jnp.exp(b_last - b)
    decay = jnp.exp(b_last[:, :, 0])
    if q is None:
        qe = None
        o_intra = None
    else:
        q = chunks(q)
        qe = q * jnp.exp(b)
        ke = k * jnp.exp(-b)
        mask = jnp.tril(jnp.ones((CHUNK, CHUNK), dtype=bool))
        A = jnp.where(mask, jnp.einsum('bnihk,bnjhk->bnhij', qe, ke), 0.0)
        o_intra = jnp.einsum('bnhij,bnjhv->bnihv', A, v)

    def step(S, xs):
        qe_n, kd_n, v_n, d_n = xs
        o = None if qe_n is None else jnp.einsum('bchk,bhkv->bchv', qe_n, S)
        S = d_n[..., None] * S + jnp.einsum('bchk,bchv->bhkv', kd_n, v_n)
        return S, o

    mv = lambda a: None if a is None else jnp.moveaxis(a, 1, 0)
    S, o_inter = lax.scan(step, s0, (mv(qe), mv(kd), mv(v), mv(decay)))
    if q is None:
        return None, S
    o = o_intra + jnp.moveaxis(o_inter, 0, 1)
    return o.reshape(B, T, H, -1), S


def hgrn2_scans(q, v, z_fwd, z_bwd, lb_fwd, lb_bwd, s_fwd, s_bwd):
    k_f, g_f = hgrn_forget(z_fwd, lb_fwd)
    k_b, g_b = hgrn_forget(z_bwd, lb_bwd)
    flip = lambda a: None if a is None else jnp.flip(a, axis=1)
    o_f, S_f = gla_chunked(q, k_f, v, g_f, s_fwd)
    o_b, S_b = gla_chunked(flip(q), flip(k_b), flip(v), flip(g_b), s_bwd)
    o = None if q is None else o_f + flip(o_b)
    return o, S_f, S_b


def branch_merge(o_hg, o_att, g_hg, g_att, r_hg, r_att, hg_norm_w, w_proj_hg, w_proj_att, w_out):
    dt = o_att.dtype
    o_hg = rms_norm(o_hg.astype(dt), hg_norm_w.reshape(HG_HEADS, HG_DV))
    y_hg = o_hg.reshape(o_hg.shape[:-2] + (HG_VAL_WIDTH,)) * jax.nn.silu(g_hg)
    y_att = o_att * jax.nn.silu(g_att)
    merged = jax.nn.sigmoid(r_hg) * (y_hg @ w_proj_hg) + jax.nn.sigmoid(r_att) * (y_att @ w_proj_att)
    return merged @ w_out


def setup_inputs(seed: int = 0) -> dict:
    key = jax.random.key(seed)
    ks = jax.random.split(key, 16)
    f32 = jnp.float32
    nrm = lambda k, s: jax.random.normal(k, s, f32)
    return {
        "x": nrm(ks[0], (BATCH, SEQ, D_MODEL)),
        "c": nrm(ks[1], (BATCH, D_MODEL)),
        "ctx": nrm(ks[2], (BATCH, CTX_LEN, D_MODEL)),
        "c_ctx": nrm(ks[3], (D_MODEL,)),
        "norm_w": 1.0 + 0.1 * nrm(ks[4], (DEPTH, D_MODEL)),
        "w_ada": 0.5 * D_MODEL ** -0.5 * nrm(ks[5], (DEPTH, D_MODEL, 3 * D_MODEL)),
        "b_ada": 0.01 * nrm(ks[6], (DEPTH, 3 * D_MODEL)),
        "w_in": D_MODEL ** -0.5 * nrm(ks[7], (DEPTH, D_MODEL, N_IN)),
        "q_norm_w": 1.0 + 0.1 * nrm(ks[8], (DEPTH, HEAD_DIM)),
        "k_norm_w": 1.0 + 0.1 * nrm(ks[9], (DEPTH, HEAD_DIM)),
        "lb_logits": 0.1 * nrm(ks[10], (2, DEPTH + 1, HG_KEY_WIDTH)),
        "hg_norm_w": 1.0 + 0.1 * nrm(ks[11], (DEPTH, HG_VAL_WIDTH)),
        "w_proj_hg": HG_VAL_WIDTH ** -0.5 * nrm(ks[12], (DEPTH, HG_VAL_WIDTH, D_MODEL)),
        "w_proj_att": ATT_WIDTH ** -0.5 * nrm(ks[13], (DEPTH, ATT_WIDTH, D_MODEL)),
        "w_out": D_MODEL ** -0.5 * nrm(ks[14], (DEPTH, D_MODEL, D_MODEL)),
        "final_norm_w": 1.0 + 0.1 * nrm(ks[15], (D_MODEL,)),
    }


def reference(x, c, ctx, c_ctx, norm_w, w_ada, b_ada, w_in, q_norm_w, k_norm_w, lb_logits,
              hg_norm_w, w_proj_hg, w_proj_att, w_out, final_norm_w):
    B, T, _ = x.shape
    L = ctx.shape[1]
    ROWS = T // GRID_W
    cos, sin = axial_rope_tables(ROWS)
    lb_all = jnp.cumsum(jax.nn.softmax(lb_logits.astype(jnp.float32), axis=1), axis=1)
    s_zero = jnp.zeros((B, HG_HEADS, HG_DK, HG_DV), jnp.float32)

    for l in range(DEPTH):
        last = l == DEPTH - 1
        shift, scale, gate = jnp.split(jax.nn.silu(c) @ w_ada[l] + b_ada[l], 3, axis=-1)
        shift_c, scale_c, gate_c = jnp.split(jax.nn.silu(c_ctx) @ w_ada[l] + b_ada[l], 3, axis=-1)
        h = modulate(rms_norm(x, norm_w[l]), shift[:, None], scale[:, None])
        h_c = modulate(rms_norm(ctx, norm_w[l]), shift_c, scale_c)

        (k_att, v_att, i_hg, f_fwd, f_bwd, q_att, g_att, q_hg, g_hg, r_hg, r_att) = split_cols(h @ w_in[l], len(COL_WIDTHS))
        n_ctx_parts = N_CTX_PARTS if last else len(COL_WIDTHS)
        w_in_c = w_in[l][:, :sum(COL_WIDTHS[:n_ctx_parts])]
        parts_c = split_cols(h_c @ w_in_c, n_ctx_parts)
        kc_att, vc_att, ic_hg, fc_fwd, fc_bwd = parts_c[:N_CTX_PARTS]

        lb_f = lb_all[0, l].reshape(HG_HEADS, HG_DK)
        lb_b = lb_all[1, l].reshape(HG_HEADS, HG_DK)

        qc_hg = None if last else jax.nn.silu(hg_heads(parts_c[7], HG_DK))
        oc_hg, S_cf, S_cb = hgrn2_scans(qc_hg, hg_heads(ic_hg, HG_DV), hg_heads(fc_fwd, HG_DK),
                                        hg_heads(fc_bwd, HG_DK), lb_f, lb_b, s_zero, s_zero)
        o_hg, _, _ = hgrn2_scans(jax.nn.silu(hg_heads(q_hg, HG_DK)), hg_heads(i_hg, HG_DV),
                                 hg_heads(f_fwd, HG_DK), hg_heads(f_bwd, HG_DK), lb_f, lb_b, S_cf, S_cb)

        qa = apply_rope(rms_norm(q_att.reshape(B, T, N_KV_HEADS, GROUP, HEAD_DIM), q_norm_w[l]), cos, sin)
        ka = apply_rope(rms_norm(k_att.reshape(B, T, N_KV_HEADS, HEAD_DIM), k_norm_w[l]), cos, sin)
        va = v_att.reshape(B, T, N_KV_HEADS, HEAD_DIM)
        kc = rms_norm(kc_att.reshape(B, L, N_KV_HEADS, HEAD_DIM), k_norm_w[l])
        vc = vc_att.reshape(B, L, N_KV_HEADS, HEAD_DIM)
        k_all = jnp.concatenate([kc, ka], axis=1)
        v_all = jnp.concatenate([vc, va], axis=1)
        o_att = block_attention(qa, k_all, v_all)

        out = branch_merge(o_hg, o_att, g_hg, g_att, r_hg, r_att,
                           hg_norm_w[l], w_proj_hg[l], w_proj_att[l], w_out[l])

        if not last:
            qc = rms_norm(parts_c[5].reshape(B, L, N_KV_HEADS, GROUP, HEAD_DIM), q_norm_w[l])
            oc_att = attend(qc, kc, vc).reshape(B, L, ATT_WIDTH)
            out_c = branch_merge(oc_hg, oc_att, parts_c[8], parts_c[6], parts_c[9], parts_c[10],
                                 hg_norm_w[l], w_proj_hg[l], w_proj_att[l], w_out[l])
            ctx = ctx + gate_c * out_c

        x = x + gate[:, None] * out

    return rms_norm(x, final_norm_w)
```

```cpp
#include <hip/hip_runtime.h>
#include <hip/hip_bf16.h>
#include <cstdio>
#include <cstdint>
#include <cmath>
constexpr int BATCH = 4, T = 2048, DM = 4096, LCTX = 256, NH = 32, NKV = 8, HD = 128, SKV = LCTX + T;
constexpr int MX = BATCH * T, MC = BATCH * LCTX, MH = MX + MC;
constexpr int NIN = 38912, NCTX = 14336, NADA = 3 * DM;
constexpr float EPS = 1e-6f;
constexpr size_t MiB = 1u << 20;
constexpr size_t WS_CTL = 0, CTL_ZERO_BYTES = 1 * MiB;
constexpr size_t WS_MODP = 1 * MiB;
constexpr size_t WS_TAB = 2 * MiB;
constexpr size_t TAB_SIN = 96 * 32 * 4, TAB_LB = 2 * 96 * 32 * 4, TAB_GATE = TAB_LB + 2 * 4096 * 4;
constexpr size_t WS_WIN = 4 * MiB;
constexpr size_t WS_WPH = 308 * MiB, WS_WPA = 340 * MiB, WS_WO = 372 * MiB;
constexpr size_t WS_H = 404 * MiB;
constexpr size_t WS_KALL = 476 * MiB, WS_VALL = 494 * MiB;
constexpr size_t WS_VHG = 512 * MiB;
constexpr size_t WS_FF = 584 * MiB, WS_FB = 728 * MiB;
constexpr size_t WS_QATT = 872 * MiB, WS_GATT = 936 * MiB, WS_QHG = 1000 * MiB, WS_GHG = 1064 * MiB, WS_RHG = 1128 * MiB, WS_RATT = 1192 * MiB;
constexpr size_t WS_OF = 1256 * MiB, WS_OB = 1384 * MiB;
constexpr size_t WS_YHG = 1512 * MiB, WS_YATT = 1576 * MiB;
constexpr size_t WS_TMP = 1640 * MiB;
constexpr size_t WS_MRG = 1768 * MiB;
constexpr size_t WS_END = 1832 * MiB;
static_assert(WS_WIN + (size_t)NIN * DM * 2 <= WS_WPH && WS_H + (size_t)MH * DM * 2 <= WS_KALL && WS_KALL + (size_t)BATCH * SKV * 1024 * 2 <= WS_VALL && WS_VALL + (size_t)BATCH * SKV * 1024 * 2 <= WS_VHG, "d_ws map");
static_assert(WS_FF + (size_t)MH * DM * 4 <= WS_FB && WS_FB + (size_t)MH * DM * 4 <= WS_QATT && WS_OF + (size_t)MX * DM * 4 <= WS_OB && WS_TMP + (size_t)MX * DM * 4 <= WS_MRG, "d_ws map");
constexpr size_t WS_XB = 3 * MiB;
constexpr int CW_BAR = 4096, CW_PANEL = 16384;
__host__ __device__ __forceinline__ size_t tm_off(int row, int col) { return ((size_t)(row >> 8) * (DM / 64) + (col >> 6)) * (256 * 64) + (row & 255) * 64 + (col & 63); }
namespace pg8 {
#define PG8_LAS __attribute__((address_space(3)))
typedef unsigned short bf16_t;
typedef short bf16x8 __attribute__((ext_vector_type(8)));
typedef float f32x4 __attribute__((ext_vector_type(4)));
typedef unsigned u32x4 __attribute__((ext_vector_type(4)));
constexpr int BM = 256, BK = 64, HALF = 128, HTB = HALF * BK * 2  , STAGE_BYTES = 8 * HTB, NXCD = 8, WGM = 4;

__host__ __device__ __forceinline__ int lds_byte(int r, int c) { const int st = (r >> 4) * 2 + (c >> 5), rr = r & 15, cc = c & 31, ob = rr * 64 + cc * 2; return st * 1024 + (ob ^ (((ob >> 9) & 1) << 5)); }
__host__ __device__ __forceinline__ void stage_rc(int b, int& R, int& C) { const int st = b / 1024, sb = b % 1024, swz = sb ^ (((sb >> 9) & 1) << 5); R = (st >> 1) * 16 + swz / 64; C = (st & 1) * 32 + (swz % 64) / 2; }
__host__ __device__ __forceinline__ int perm32(int rho) { const int n = rho >> 4, i = rho & 15; return 8 * (i >> 2) + 4 * n + (i & 3); }

struct Unit { int pm, pn; };
struct Gemm { const bf16_t* A; const bf16_t* Bt; int M, N, K; };

struct StaticOrder {
    int nM, nN, nwg, G, c;
    __host__ __device__ void init(int M, int N, int G_, int c_) { nM = M / BM; nN = N / BM; nwg = nM * nN; G = G_; c = c_; }
    __host__ __device__ bool next(int i, Unit& u) const {
        const long L = (long)i * G + c; if (L >= nwg) return false;
        int wgid = (int)L; { const int q = nwg / NXCD, r = nwg % NXCD, xcd = wgid % NXCD, off = wgid / NXCD; wgid = (xcd < r ? xcd * (q + 1) : r * (q + 1) + (xcd - r) * q) + off; }
        const int nig = WGM * nN, gid = wgid / nig, fm = gid * WGM, gsz = (nM - fm) < WGM ? (nM - fm) : WGM;
        u.pm = fm + ((wgid % nig) % gsz); u.pn = (wgid % nig) / gsz; return true;
    }
    __device__ __forceinline__ void a_ready(const Unit&) const {}
    __device__ __forceinline__ void done(const Unit&) const {}
};

__device__ __forceinline__ unsigned cvt_pk_bf16(float lo, float hi) { unsigned r; asm volatile("v_cvt_pk_bf16_f32 %0, %1, %2" : "=v"(r) : "v"(lo), "v"(hi)); return r; }
typedef float f32x2 __attribute__((ext_vector_type(2)));
typedef _Float16 f16x8 __attribute__((ext_vector_type(8)));
__device__ __forceinline__ float sigm(float v) { return __builtin_amdgcn_rcpf(1.0f + __builtin_amdgcn_exp2f(-1.4426950408889634f * v)); }
__device__ __forceinline__ float bf_lo(unsigned w) { return __uint_as_float(w << 16); }
__device__ __forceinline__ float bf_hi(unsigned w) { return __uint_as_float(w & 0xffff0000u); }
struct InOrder {
    StaticOrder so; int G, c;
    __host__ __device__ void init(int G_, int c_) { so.init(MX, NIN, G_, c_); G = G_; c = c_; }
    __host__ __device__ bool next(int i, Unit& u) const {
        if (G == 256 && so.nwg == 19 * 256) {
            if (i < 19) { const int x = c & 7, q = c >> 3; u.pm = 4 * x + (q & 3); u.pn = 8 * i + (q >> 2); return true; }
        } else
        if (so.next(i, u)) return true;
        const long L = (long)i * G + c - so.nwg; if (L >= 4 * 56) return false;
        if (G == 256 && so.nwg % 256 == 0) {
            const int x = c & 7, j = c >> 3; if (j >= 28) return false;
            u.pm = 32 + (j & 3); u.pn = 7 * x + (j >> 2); return true; }
        u.pm = 32 + (int)(L & 3); u.pn = (int)(L >> 2); return true;
    }
    __device__ __forceinline__ void a_ready(const Unit&) const {}
    __device__ __forceinline__ void done(const Unit&) const {}
};
struct EpiIn {
    static constexpr bool PERM = true, AFTER_DRAIN = false;
    unsigned char* ws; const float* lb;
    __device__ __forceinline__ void operator()(const f32x4 (&acc)[2][2][4][2], const Unit& u, int wr, int wc, int fr, int fq) const {
        const int pn = u.pn, pm = u.pm;
        int mode, ld, cpn, hrows = 0, hpb = NH; size_t off;
        if (pn < 4)        { mode = 0; off = WS_KALL; ld = 1024; cpn = pn; hrows = SKV; hpb = NKV; }
        else if (pn < 8)   { mode = 0; off = WS_VALL; ld = 1024; cpn = pn - 4; hrows = SKV; hpb = NKV; }
        else if (pn < 24)  { mode = 0; off = WS_VHG;  ld = DM; cpn = pn - 8; hrows = SKV; }
        else if (pn < 40)  { mode = 3; off = WS_FF;   ld = DM; cpn = pn - 24; hrows = SKV; }
        else if (pn < 56)  { mode = 4; off = WS_FB;   ld = DM; cpn = pn - 40; hrows = SKV; }
        else if (pn < 72)  { mode = 0; off = WS_QATT; ld = DM; cpn = pn - 56; hrows = T; }
        else if (pn < 88)  { mode = 0; off = WS_GATT; ld = DM; cpn = pn - 72; hrows = T; }
        else if (pn < 104) { mode = 1; off = WS_QHG;  ld = DM; cpn = pn - 88; hrows = T; }
        else if (pn < 120) { mode = 0; off = WS_GHG;  ld = DM; cpn = pn - 104; hrows = T; }
        else if (pn < 136) { mode = 0; off = WS_RHG;  ld = DM; cpn = pn - 120; }
        else               { mode = 0; off = WS_RATT; ld = DM; cpn = pn - 136; }
        int row0 = pm * 256;
        size_t hm_step = 0;
        if (hrows) { const int bb = pm < 32 ? pm >> 3 : pm - 32, pos0 = pm < 32 ? (hrows - T) + (pm & 7) * 256 : 0;
            off += (((size_t)(bb * hpb + cpn * 2) * hrows + pos0) * HD) * 2; row0 = 0; ld = HD; hm_step = (size_t)hrows * HD; }
        const int rloc = wr * 64 + fr, cloc = cpn * 256 + wc * 32 + 8 * fq, dcol = hrows ? wc * 32 + 8 * fq : cloc; const size_t bjs = hrows ? hm_step : (size_t)HALF;
        if (mode >= 3) {
            _Float16* base = (_Float16*)(ws + off);
#pragma unroll
            for (int ai = 0; ai < 2; ++ai)
#pragma unroll
                for (int m = 0; m < 4; ++m) { _Float16* rowp = base + (size_t)(row0 + rloc + ai * HALF + m * 16) * ld + dcol;
#pragma unroll
                    for (int bj = 0; bj < 2; ++bj) { const f32x4 v0 = acc[ai][bj][m][0], v1 = acc[ai][bj][m][1]; f16x8 o;
#pragma unroll
                        for (int j = 0; j < 4; ++j) { o[j] = (_Float16)v0[j]; o[4 + j] = (_Float16)v1[j]; }
                        *(f16x8*)(rowp + bj * bjs) = o; } }
        } else {
            bf16_t* base = (bf16_t*)(ws + off);
#pragma unroll
            for (int ai = 0; ai < 2; ++ai)
#pragma unroll
                for (int m = 0; m < 4; ++m) { bf16_t* rowp = base + (size_t)(row0 + rloc + ai * HALF + m * 16) * ld + dcol;
#pragma unroll
                    for (int bj = 0; bj < 2; ++bj) { f32x4 v0 = acc[ai][bj][m][0], v1 = acc[ai][bj][m][1];
                        if (mode != 0) {
#pragma unroll
                            for (int j = 0; j < 4; ++j) { v0[j] *= sigm(v0[j]); v1[j] *= sigm(v1[j]); } }
                        u32x4 w; w.x = cvt_pk_bf16(v0[0], v0[1]); w.y = cvt_pk_bf16(v0[2], v0[3]); w.z = cvt_pk_bf16(v1[0], v1[1]); w.w = cvt_pk_bf16(v1[2], v1[3]);
                        *(u32x4*)(rowp + bj * bjs) = w; } }
        }
    }
};
struct EpiProjA {
    static constexpr bool PERM = true, AFTER_DRAIN = false;
    const bf16_t* R; float* tmp;
    __device__ __forceinline__ void operator()(const f32x4 (&acc)[2][2][4][2], const Unit& u, int wr, int wc, int fr, int fq) const {
        const int row0 = u.pm * BM + wr * 64 + fr, col0 = u.pn * BM + wc * 32 + 8 * fq;
#pragma unroll
        for (int ai = 0; ai < 2; ++ai)
#pragma unroll
            for (int m = 0; m < 4; ++m) { const size_t ro = (size_t)(row0 + ai * HALF + m * 16) * DM + col0;
#pragma unroll
                for (int bj = 0; bj < 2; ++bj) { const u32x4 r = *(const u32x4*)(R + ro + bj * HALF); const f32x4 v0 = acc[ai][bj][m][0], v1 = acc[ai][bj][m][1];
                    const f32x4 o0 = {v0[0] * sigm(bf_lo(r.x)), v0[1] * sigm(bf_hi(r.x)), v0[2] * sigm(bf_lo(r.y)), v0[3] * sigm(bf_hi(r.y))};
                    const f32x4 o1 = {v1[0] * sigm(bf_lo(r.z)), v1[1] * sigm(bf_hi(r.z)), v1[2] * sigm(bf_lo(r.w)), v1[3] * sigm(bf_hi(r.w))};
                    *(f32x4*)(tmp + ro + bj * HALF) = o0; *(f32x4*)(tmp + ro + bj * HALF + 4) = o1; } }
    }
};
struct EpiProjB {
    static constexpr bool PERM = true, AFTER_DRAIN = false;
    const bf16_t* R; const float* tmp; bf16_t* O;
    __device__ __forceinline__ void operator()(const f32x4 (&acc)[2][2][4][2], const Unit& u, int wr, int wc, int fr, int fq) const {
        const int row0 = u.pm * BM + wr * 64 + fr, col0 = u.pn * BM + wc * 32 + 8 * fq;
#pragma unroll
        for (int ai = 0; ai < 2; ++ai)
#pragma unroll
            for (int m = 0; m < 4; ++m) { const size_t ro = (size_t)(row0 + ai * HALF + m * 16) * DM + col0;
#pragma unroll
                for (int bj = 0; bj < 2; ++bj) { const u32x4 r = *(const u32x4*)(R + ro + bj * HALF); const f32x4 t0 = *(const f32x4*)(tmp + ro + bj * HALF), t1 = *(const f32x4*)(tmp + ro + bj * HALF + 4);
                    const f32x4 v0 = acc[ai][bj][m][0], v1 = acc[ai][bj][m][1];
                    const f32x4 o0 = {t0[0] + v0[0] * sigm(bf_lo(r.x)), t0[1] + v0[1] * sigm(bf_hi(r.x)), t0[2] + v0[2] * sigm(bf_lo(r.y)), t0[3] + v0[3] * sigm(bf_hi(r.y))};
                    const f32x4 o1 = {t1[0] + v1[0] * sigm(bf_lo(r.z)), t1[1] + v1[1] * sigm(bf_hi(r.z)), t1[2] + v1[2] * sigm(bf_lo(r.w)), t1[3] + v1[3] * sigm(bf_hi(r.w))};
                    u32x4 w; w.x = cvt_pk_bf16(o0[0], o0[1]); w.y = cvt_pk_bf16(o0[2], o0[3]); w.z = cvt_pk_bf16(o1[0], o1[1]); w.w = cvt_pk_bf16(o1[2], o1[3]);
                    *(u32x4*)(O + tm_off(row0 + ai * HALF + m * 16, col0 + bj * HALF)) = w; } }
    }
};
struct EpiOut {
    static constexpr bool PERM = false, AFTER_DRAIN = false;
    const float* x; const float* gate; float* out;
    __device__ __forceinline__ void operator()(const f32x4 (&acc)[2][2][4][2], const Unit& u, int wr, int wc, int fr, int fq) const {
        const int row0 = u.pm * BM + wr * 64 + fr, col0 = u.pn * BM + wc * 32 + 4 * fq;
        const float* gp = gate + (u.pm >> 3) * DM + col0;
        f32x4 gv[2][2];
#pragma unroll
        for (int bj = 0; bj < 2; ++bj)
#pragma unroll
            for (int n = 0; n < 2; ++n) gv[bj][n] = *(const f32x4*)(gp + bj * HALF + n * 16);
#pragma unroll
        for (int ai = 0; ai < 2; ++ai)
#pragma unroll
            for (int m = 0; m < 4; ++m) { const size_t ro = (size_t)(row0 + ai * HALF + m * 16) * DM + col0;
#pragma unroll
                for (int bj = 0; bj < 2; ++bj)
#pragma unroll
                    for (int n = 0; n < 2; ++n) { const f32x4 xv = *(const f32x4*)(x + ro + bj * HALF + n * 16); *(f32x4*)(out + ro + bj * HALF + n * 16) = xv + gv[bj][n] * acc[ai][bj][m][n]; } }
    }
};
struct RoundOrder {
    int pm, pn;
    __host__ __device__ void init(int vcu, int rnd) { const int x = vcu >> 5, q = vcu & 31; pm = 16 * rnd + 4 * (x >> 1) + (q & 3); pn = 8 * (x & 1) + (q >> 2); }
    __host__ __device__ bool next(int i, Unit& u) const { if (i > 0) return false; u.pm = pm; u.pn = pn; return true; }
    __device__ __forceinline__ void a_ready(const Unit&) const {}
    __device__ __forceinline__ void done(const Unit&) const {}
};
struct EpiOutNorm {
    static constexpr bool PERM = false, AFTER_DRAIN = true, HAS_MID = false;
    const float* x; const float* gate; const float* fw; float* out; unsigned* xbuf; unsigned* cnt; unsigned* tmo;
    __device__ __forceinline__ void early(f32x4 (&)[2][2][4][2], const Unit&, int, int, int, int, PG8_LAS unsigned char*) const {}
    __device__ __forceinline__ void fused(f32x4 (&acc)[2][2][4][2], const Unit& u, int wr, int wc, int fr, int fq, PG8_LAS unsigned char* lds, int wid, int lane) const {
        PG8_LAS float* P = (PG8_LAS float*)lds; PG8_LAS float* R = P + 1024; PG8_LAS unsigned* flag = (PG8_LAS unsigned*)(R + 256);
        const int row0 = u.pm * BM + wr * 64 + fr, col0 = u.pn * BM + wc * 32 + 4 * fq;
        {
            const float* gp = gate + (u.pm >> 3) * DM + col0;
            f32x4 gv[2][2];
#pragma unroll
            for (int bj = 0; bj < 2; ++bj)
#pragma unroll
                for (int n = 0; n < 2; ++n) gv[bj][n] = *(const f32x4*)(gp + bj * HALF + n * 16);
            f32x4 xv[2][2][2];
#define EON_LOAD(slot, g) do { const size_t ro_ = (size_t)(row0 + ((g) >> 2) * HALF + ((g) & 3) * 16) * DM + col0; _Pragma("unroll") for (int bj = 0; bj < 2; ++bj) _Pragma("unroll") for (int n = 0; n < 2; ++n) xv[slot][bj][n] = *(const f32x4*)(x + ro_ + bj * HALF + n * 16); } while (0)
            EON_LOAD(0, 0);
#pragma unroll
            for (int g = 0; g < 8; ++g) { const int ai = g >> 2, m = g & 3, sl = g & 1;
                if (g + 1 < 8) { if (sl) EON_LOAD(0, g + 1); else EON_LOAD(1, g + 1); }
#pragma unroll
                for (int bj = 0; bj < 2; ++bj)
#pragma unroll
                    for (int n = 0; n < 2; ++n) acc[ai][bj][m][n] = xv[sl][bj][n] + gv[bj][n] * acc[ai][bj][m][n];
                asm volatile("" : "+v"(acc[ai][0][m][0]), "+v"(acc[ai][0][m][1]), "+v"(acc[ai][1][m][0]), "+v"(acc[ai][1][m][1]) :: "memory"); }
#undef EON_LOAD
        }
#pragma unroll
        for (int ai = 0; ai < 2; ++ai)
#pragma unroll
            for (int m = 0; m < 4; ++m) { float s = 0.f;
#pragma unroll
                for (int bj = 0; bj < 2; ++bj)
#pragma unroll
                    for (int n = 0; n < 2; ++n) { const f32x4 v = acc[ai][bj][m][n]; s += (v[0] * v[0] + v[1] * v[1]) + (v[2] * v[2] + v[3] * v[3]); }
                s += __shfl_xor(s, 16); s += __shfl_xor(s, 32);
                if (fq == 0) P[(ai * HALF + wr * 64 + m * 16 + fr) * 4 + wc] = s; }
        asm volatile("s_waitcnt lgkmcnt(0)" ::: "memory"); __builtin_amdgcn_s_barrier(); asm volatile("" ::: "memory");
        const int row = wid * 32 + (lane & 31);
        if (lane < 32) { const f32x4 a = *(const PG8_LAS f32x4*)(P + row * 4);
            __hip_atomic_store(xbuf + (size_t)(u.pm * BM + row) * 16 + u.pn, __float_as_uint((a[0] + a[1]) + (a[2] + a[3])), __ATOMIC_RELAXED, __HIP_MEMORY_SCOPE_AGENT); }
        asm volatile("s_waitcnt vmcnt(0)" ::: "memory");
        if (lane == 0) __hip_atomic_fetch_add(cnt + 64 * u.pm, 1u, __ATOMIC_RELAXED, __HIP_MEMORY_SCOPE_AGENT);
        if (wid == 0) {
            bool dead = false;
            for (unsigned spins = 0;; ++spins) {
                if ((unsigned)__builtin_amdgcn_readfirstlane(__hip_atomic_load(cnt + 64 * u.pm, __ATOMIC_RELAXED, __HIP_MEMORY_SCOPE_AGENT)) >= 128u) break;
                if (spins > (1u << 18)) { if (lane == 0) __hip_atomic_store(tmo, 1u, __ATOMIC_RELAXED, __HIP_MEMORY_SCOPE_AGENT); dead = true; break; }
                __builtin_amdgcn_s_sleep(2);
            }
            __builtin_amdgcn_fence(__ATOMIC_ACQUIRE, "agent");
            if (lane == 0) flag[0] = dead ? 1u : 0u;
        }
        asm volatile("s_waitcnt vmcnt(0) lgkmcnt(0)" ::: "memory"); __builtin_amdgcn_s_barrier(); asm volatile("" ::: "memory");
        const bool bad = flag[0] != 0u;
        if (lane < 32) { const unsigned* slot = xbuf + (size_t)(u.pm * BM + row) * 16; float ss = 0.f;
#pragma unroll
            for (int t = 0; t < 16; ++t) ss += __uint_as_float(__hip_atomic_load(slot + t, __ATOMIC_RELAXED, __HIP_MEMORY_SCOPE_AGENT));
            R[row] = bad ? __builtin_nanf("") : 1.0f / sqrtf(ss * (1.0f / DM) + EPS); }
        asm volatile("s_waitcnt lgkmcnt(0)" ::: "memory"); __builtin_amdgcn_s_barrier(); asm volatile("" ::: "memory");
        f32x4 wv[2][2];
#pragma unroll
        for (int bj = 0; bj < 2; ++bj)
#pragma unroll
            for (int n = 0; n < 2; ++n) wv[bj][n] = *(const f32x4*)(fw + col0 + bj * HALF + n * 16);
#pragma unroll
        for (int ai = 0; ai < 2; ++ai)
#pragma unroll
            for (int m = 0; m < 4; ++m) { const int rl = ai * HALF + wr * 64 + m * 16 + fr; const float rs = R[rl]; float* op = out + (size_t)(u.pm * BM + rl) * DM + col0;
#pragma unroll
                for (int bj = 0; bj < 2; ++bj)
#pragma unroll
                    for (int n = 0; n < 2; ++n) *(f32x4*)(op + bj * HALF + n * 16) = acc[ai][bj][m][n] * rs * wv[bj][n];
                asm volatile("" ::: "memory"); }
    }
};
template <class Epi, class Sched, bool ALIGN_EPI = false, bool SP2 = false, bool ATILED = false>
__device__ __forceinline__ void gemm_phase(PG8_LAS unsigned char* lds, const Gemm g, const Sched& S, const Epi& E) {
    const int tid = threadIdx.x, wid = __builtin_amdgcn_readfirstlane(tid >> 6), lane = tid & 63, wr = wid >> 2, wc = wid & 3, fr = lane & 15, fq = lane >> 4;
    const int K = g.K, nt = K / BK;
    unsigned voffA[2], voffB[2];
#pragma unroll
    for (int i = 0; i < 2; ++i) { int R, C; stage_rc(tid * 16 + i * 8192, R, C); const int Rb = Epi::PERM ? ((R & ~31) + perm32(R & 31)) : R;
        voffA[i] = (unsigned)(R * (ATILED ? BK : K) + C) * 2u; voffB[i] = (unsigned)(Rb * BK + C) * 2u; }
    const size_t kstep = (size_t)(BK * 2);
    const size_t hstep = (size_t)HALF * K * 2;
    const size_t tstep = 2 * hstep;
    const size_t kstepA = ATILED ? (size_t)BM * BK * 2 : kstep, hstepA = ATILED ? (size_t)HALF * BK * 2 : hstep;
    const size_t kstepB = (size_t)BM * BK * 2, hstepB = (size_t)HALF * BK * 2;
    const unsigned ldsw = (unsigned)wid * 1024u;
    const int aoff = lds_byte(wr * 64 + fr, fq * 8), boff = lds_byte(wc * 32 + fr, fq * 8);
#define PG8_SA(b, h) (((b) * 2 + (h)) * HTB)
#define PG8_SB(b, h) ((4 + (b) * 2 + (h)) * HTB)
#define PG8_STAGE(bufoff, gbase, voff) do { _Pragma("unroll") for (int _i = 0; _i < 2; ++_i) \
        __builtin_amdgcn_global_load_lds((const unsigned*)((const char*)(gbase) + (voff)[_i]), (PG8_LAS unsigned*)(lds + (bufoff) + ldsw + _i * 8192), 16, 0, 0); } while (0)
#define PG8_LDA(dst, b, h) do { _Pragma("unroll") for (int m = 0; m < 4; ++m) _Pragma("unroll") for (int k = 0; k < 2; ++k) dst[m][k] = *(const PG8_LAS bf16x8*)(lds + PG8_SA(b, h) + aoff + m * 2048 + k * 1024); } while (0)
#define PG8_LDB(dst, b, h) do { _Pragma("unroll") for (int n = 0; n < 2; ++n) _Pragma("unroll") for (int k = 0; k < 2; ++k) dst[n][k] = *(const PG8_LAS bf16x8*)(lds + PG8_SB(b, h) + boff + n * 2048 + k * 1024); } while (0)
#define PG8_MMA(ai, bj, At, Bt) do { __builtin_amdgcn_s_setprio(1); _Pragma("unroll") for (int m = 0; m < 4; ++m) _Pragma("unroll") for (int n = 0; n < 2; ++n) _Pragma("unroll") for (int k = 0; k < 2; ++k) \
        acc[ai][bj][m][n] = __builtin_amdgcn_mfma_f32_16x16x32_bf16(Bt[n][k], At[m][k], acc[ai][bj][m][n], 0, 0, 0); __builtin_amdgcn_s_setprio(0); } while (0)
#define PG8_WAIT_V(n) asm volatile("s_waitcnt vmcnt(" #n ")" ::: "memory")
#define PG8_WAIT_L(n) asm volatile("s_waitcnt lgkmcnt(" #n ")" ::: "memory")
#define PG8_BAR __builtin_amdgcn_s_barrier()
#define PG8_SCHED __builtin_amdgcn_sched_barrier(0)
    Unit cur, nxt; int ui = 0;
    if (!S.next(0, cur)) return;
    f32x4 acc[2][2][4][2];
#pragma unroll
    for (int a = 0; a < 2; ++a)
#pragma unroll
        for (int b = 0; b < 2; ++b)
#pragma unroll
            for (int m = 0; m < 4; ++m)
#pragma unroll
                for (int n = 0; n < 2; ++n) acc[a][b][m][n] = (f32x4){0.f, 0.f, 0.f, 0.f};
    bf16x8 At[4][2], B0[2][2], B1[2][2];
    const char* cA = (const char*)g.A + (size_t)cur.pm * tstep; const char* cB = (const char*)g.Bt + (size_t)cur.pn * tstep;
    S.a_ready(cur);
    if constexpr (SP2) {
        PG8_STAGE(PG8_SB(0, 0), cB, voffB); PG8_STAGE(PG8_SB(0, 1), cB + hstepB, voffB); PG8_STAGE(PG8_SA(0, 0), cA, voffA); PG8_STAGE(PG8_SA(0, 1), cA + hstepA, voffA);
        if (wr == 1) PG8_BAR;
        PG8_WAIT_V(2); PG8_BAR;
        PG8_STAGE(PG8_SB(1, 0), cB + kstepB, voffB); PG8_STAGE(PG8_SA(1, 0), cA + kstepA, voffA); PG8_STAGE(PG8_SB(1, 1), cB + hstepB + kstepB, voffB);
        PG8_WAIT_V(6); PG8_BAR;
    } else {
        PG8_STAGE(PG8_SB(0, 0), cB, voffB); PG8_STAGE(PG8_SA(0, 0), cA, voffA); PG8_STAGE(PG8_SB(0, 1), cB + hstepB, voffB); PG8_STAGE(PG8_SA(0, 1), cA + hstepA, voffA);
        if (wr == 1) PG8_BAR;
        PG8_WAIT_V(4); PG8_BAR;
        PG8_STAGE(PG8_SB(1, 0), cB + kstepB, voffB); PG8_STAGE(PG8_SA(1, 0), cA + kstepA, voffA); PG8_STAGE(PG8_SB(1, 1), cB + hstepB + kstepB, voffB);
        PG8_WAIT_V(6); PG8_BAR;
    }
    for (;;) {
        const bool has_next = S.next(ui + 1, nxt);
        const char* nA = has_next ? (const char*)g.A + (size_t)nxt.pm * tstep : cA; const char* nB = has_next ? (const char*)g.Bt + (size_t)nxt.pn * tstep : cB;
        for (int t = 0; t < nt; t += 2) {
            const bool last = (t == nt - 2);
            const char* a1 = cA + (size_t)(t + 1) * kstepA;
            const char* a2 = last ? nA : cA + (size_t)(t + 2) * kstepA; const char* b2 = last ? nB : cB + (size_t)(t + 2) * kstepB;
            const char* a3 = a2 + kstepA; const char* b3 = b2 + kstepB;
            if (last && has_next) S.a_ready(nxt);
            if constexpr (SP2) {
            PG8_LDB(B0, 0, 0); PG8_LDB(B1, 0, 1); PG8_SCHED; PG8_LDA(At, 0, 0); PG8_STAGE(PG8_SA(1, 1), a1 + hstepA, voffA);
            PG8_WAIT_V(8); PG8_WAIT_L(0); PG8_BAR; PG8_MMA(0, 0, At, B0); PG8_MMA(0, 1, At, B1); PG8_BAR; PG8_SCHED;
            PG8_LDA(At, 0, 1); PG8_STAGE(PG8_SB(0, 0), b2, voffB); PG8_STAGE(PG8_SB(0, 1), b2 + hstepB, voffB); PG8_STAGE(PG8_SA(0, 0), a2, voffA);
            PG8_WAIT_V(8); PG8_WAIT_L(0); PG8_BAR; PG8_MMA(1, 0, At, B0); PG8_MMA(1, 1, At, B1); PG8_BAR; PG8_SCHED;
            PG8_LDB(B0, 1, 0); PG8_LDB(B1, 1, 1); PG8_SCHED; PG8_LDA(At, 1, 0); PG8_STAGE(PG8_SA(0, 1), a2 + hstepA, voffA);
            PG8_WAIT_V(8); PG8_WAIT_L(0); PG8_BAR; PG8_MMA(0, 0, At, B0); PG8_MMA(0, 1, At, B1); PG8_BAR; PG8_SCHED;
            PG8_LDA(At, 1, 1); PG8_STAGE(PG8_SB(1, 0), b3, voffB); PG8_STAGE(PG8_SB(1, 1), b3 + hstepB, voffB); PG8_STAGE(PG8_SA(1, 0), a3, voffA);
            PG8_WAIT_V(8); PG8_WAIT_L(0); PG8_BAR; PG8_MMA(1, 0, At, B0); PG8_MMA(1, 1, At, B1); PG8_BAR; PG8_SCHED;
            } else {
            PG8_LDB(B0, 0, 0); PG8_SCHED; PG8_LDA(At, 0, 0); PG8_STAGE(PG8_SA(1, 1), a1 + hstepA, voffA);
            PG8_WAIT_L(8); PG8_BAR; PG8_WAIT_L(0); PG8_MMA(0, 0, At, B0); PG8_BAR; PG8_SCHED;
            PG8_LDB(B1, 0, 1); PG8_STAGE(PG8_SB(0, 0), b2, voffB);
            PG8_BAR; PG8_WAIT_L(0); PG8_MMA(0, 1, At, B1); PG8_BAR;
            PG8_LDA(At, 0, 1); PG8_STAGE(PG8_SA(0, 0), a2, voffA);
            PG8_BAR; PG8_WAIT_L(0); PG8_MMA(1, 0, At, B0); PG8_BAR; PG8_SCHED;
            PG8_STAGE(PG8_SB(0, 1), b2 + hstepB, voffB);
            PG8_WAIT_V(6); PG8_BAR; PG8_MMA(1, 1, At, B1); PG8_BAR;
            PG8_LDB(B0, 1, 0); PG8_SCHED; PG8_LDA(At, 1, 0); PG8_STAGE(PG8_SA(0, 1), a2 + hstepA, voffA);
            PG8_WAIT_L(8); PG8_BAR; PG8_WAIT_L(0); PG8_MMA(0, 0, At, B0); PG8_BAR; PG8_SCHED;
            PG8_LDB(B1, 1, 1); PG8_STAGE(PG8_SB(1, 0), b3, voffB);
            PG8_BAR; PG8_WAIT_L(0); PG8_MMA(0, 1, At, B1); PG8_BAR;
            PG8_LDA(At, 1, 1); PG8_STAGE(PG8_SA(1, 0), a3, voffA);
            PG8_BAR; PG8_WAIT_L(0); PG8_MMA(1, 0, At, B0); PG8_BAR; PG8_SCHED;
            PG8_STAGE(PG8_SB(1, 1), b3 + hstepB, voffB);
            PG8_WAIT_V(6); PG8_BAR; PG8_MMA(1, 1, At, B1); PG8_BAR;
            }
        }
        if constexpr (ALIGN_EPI) { if (wr == 0) PG8_BAR; }
        if constexpr (!Epi::AFTER_DRAIN) { E(acc, cur, wr, wc, fr, fq); S.done(cur); }
        else { if (has_next) { E.early(acc, cur, wr, wc, fr, fq, lds); S.done(cur); } }
        if (!has_next) break;
#pragma unroll
        for (int a = 0; a < 2; ++a)
#pragma unroll
            for (int b = 0; b < 2; ++b)
#pragma unroll
                for (int m = 0; m < 4; ++m)
#pragma unroll
                    for (int n = 0; n < 2; ++n) acc[a][b][m][n] = (f32x4){0.f, 0.f, 0.f, 0.f};
        cur = nxt; cA = nA; cB = nB; ++ui;
        if constexpr (ALIGN_EPI) { if (wr == 1) PG8_BAR; }
    }
    PG8_WAIT_V(0);
    if constexpr (!ALIGN_EPI) { if (wr == 0) PG8_BAR; }
    PG8_BAR;
    if constexpr (Epi::AFTER_DRAIN) { E.fused(acc, cur, wr, wc, fr, fq, lds, wid, lane); S.done(cur); }
#undef PG8_SA
#undef PG8_SB
#undef PG8_STAGE
#undef PG8_LDA
#undef PG8_LDB
#undef PG8_MMA
#undef PG8_WAIT_V
#undef PG8_WAIT_L
#undef PG8_BAR
#undef PG8_SCHED
}
}
namespace attn {
using bf16 = __hip_bfloat16;
constexpr int D = 128, NW = 8, QBLK = 32, KVBLK = 64;
constexpr float SCALE = 0.088388347648318440f;
constexpr float THR = 8.f;
#ifndef ATTN_SDEPTH
#define ATTN_SDEPTH 1
#endif
constexpr int SDEPTH = ATTN_SDEPTH;
constexpr int LDQ = D, LDK = D, LDO = D;
constexpr size_t SHM_V = KVBLK * D * 2, SHM_K = KVBLK * D * 2, SHM_ATTN = 2 * SHM_V + 2 * SHM_K + NW * 64 * 4, SHM_TOTAL = SHM_ATTN + NW * QBLK * D * 2;
using bf16x8 = __attribute__((ext_vector_type(8))) short;
using s16x4  = __attribute__((ext_vector_type(4))) short;
using f32x16 = __attribute__((ext_vector_type(16))) float;
using u32x4  = __attribute__((ext_vector_type(4))) unsigned;
#define KSWZ(row, colB) ((row) * 256 + ((colB) ^ (((row) & 7) << 4)))
#define SBAR() __builtin_amdgcn_sched_barrier(0)
__device__ __forceinline__ int crow(int r, int hi) { return (r & 3) + 8 * (r >> 2) + 4 * hi; }
__device__ __forceinline__ unsigned cvtpk(float lo, float hi) { unsigned r; asm volatile("v_cvt_pk_bf16_f32 %0, %1, %2" : "=v"(r) : "v"(lo), "v"(hi)); return r; }
__device__ __forceinline__ bf16x8 ld8(const bf16* p) { return *reinterpret_cast<const bf16x8*>(p); }
__device__ __forceinline__ void partialSM(f32x16& p0, f32x16& p1, float& m_reg, float& mn, float& alpha) {
  constexpr float C = SCALE * 1.4426950408889634f;
  float pmax = p0[0]; for (int r = 1; r < 16; ++r) pmax = fmaxf(pmax, p0[r]); for (int r = 0; r < 16; ++r) pmax = fmaxf(pmax, p1[r]);
  { auto rr = __builtin_amdgcn_permlane32_swap(__float_as_uint(pmax), __float_as_uint(pmax), false, false);
    pmax = fmaxf(__uint_as_float(rr[0]), __uint_as_float(rr[1])); }
  if (__builtin_expect(__all(pmax - m_reg <= THR / SCALE), 1)) { mn = m_reg; alpha = 1.f; }
  else { mn = fmaxf(m_reg, pmax); alpha = __builtin_amdgcn_exp2f((m_reg - mn) * C); m_reg = mn; }
  float mnC = -mn * C;
  for (int r = 0; r < 16; ++r) p0[r] = fmaf(p0[r], C, mnC); for (int r = 0; r < 16; ++r) p1[r] = fmaf(p1[r], C, mnC);
  for (int r = 0; r < 16; ++r) p0[r] = __builtin_amdgcn_exp2f(p0[r]);
}
__device__ __forceinline__ void finishSM(f32x16& p0, f32x16& p1, float alpha, float& l_reg, bf16x8& pa0, bf16x8& pa1, bf16x8& pa2, bf16x8& pa3) {
  for (int r = 0; r < 16; ++r) p1[r] = __builtin_amdgcn_exp2f(p1[r]);
  float ps = 0; for (int r = 0; r < 16; ++r) ps += p0[r]; for (int r = 0; r < 16; ++r) ps += p1[r];
  { auto rr = __builtin_amdgcn_permlane32_swap(__float_as_uint(ps), __float_as_uint(ps), false, false);
    ps = __uint_as_float(rr[0]) + __uint_as_float(rr[1]); }
  l_reg = l_reg * alpha + ps;
#define PK4(P, BASE, OUT) do { unsigned a0 = cvtpk(P[BASE + 0], P[BASE + 1]), a1 = cvtpk(P[BASE + 2], P[BASE + 3]);   \
    unsigned b0 = cvtpk(P[BASE + 4], P[BASE + 5]), b1 = cvtpk(P[BASE + 6], P[BASE + 7]);                              \
    auto r0 = __builtin_amdgcn_permlane32_swap(a0, b0, false, false); auto r1 = __builtin_amdgcn_permlane32_swap(a1, b1, false, false); \
    u32x4 w = {r0[0], r1[0], r0[1], r1[1]}; OUT = *reinterpret_cast<bf16x8*>(&w); } while (0)
  PK4(p0, 0, pa0); PK4(p0, 8, pa1); PK4(p1, 0, pa2); PK4(p1, 8, pa3);
#undef PK4
}
__device__ __forceinline__ void qkt(f32x16& p0, f32x16& p1, const bf16* Ks, const bf16x8* qr, int r32, int hi) {
  p0 = f32x16{}; p1 = f32x16{};
  for (int d0 = 0; d0 < 8; ++d0) { int cb = (d0 * 16 + hi * 8) * 2;
    bf16x8 b0 = *reinterpret_cast<const bf16x8*>((const char*)Ks + KSWZ(r32, cb));
    bf16x8 b1 = *reinterpret_cast<const bf16x8*>((const char*)Ks + KSWZ(32 + r32, cb));
    p0 = __builtin_amdgcn_mfma_f32_32x32x16_bf16(b0, qr[d0], p0, 0, 0, 0);
    p1 = __builtin_amdgcn_mfma_f32_32x32x16_bf16(b1, qr[d0], p1, 0, 0, 0); }
}
__device__ __forceinline__ int v_st(int k, int c) { const int kk = (k & ~0xC) | ((k & 4) << 1) | ((k & 8) >> 1); return ((kk >> 3) * 4 + (c >> 5)) * 512 + ((kk & 7) * 32 + (c & 31)) * 2; }
__device__ __forceinline__ int v_rd_base(int lane) { return ((lane & 3) << 3) | (((lane >> 2) & 3) << 6) | (((lane >> 4) & 1) << 5) | (((lane >> 5) & 1) << 8); }
constexpr int v_rd_off(int d0, int ks, int half) { return d0 * 512 + ks * 4096 + half * 2048; }
template <int OFF> __device__ __forceinline__ s16x4 tr_read(int vb) {
  s16x4 r; asm volatile("ds_read_b64_tr_b16 %0, %1 offset:%2" : "=&v"(r) : "v"(vb), "i"(OFF) : "memory"); return r;
}
template <int D0> __device__ __forceinline__ void pv_one(f32x16& od, int vb, bf16x8 pa0, bf16x8 pa1, bf16x8 pa2, bf16x8 pa3) {
  const s16x4 l0 = tr_read<v_rd_off(D0, 0, 0)>(vb), h0 = tr_read<v_rd_off(D0, 0, 1)>(vb), l1 = tr_read<v_rd_off(D0, 1, 0)>(vb), h1 = tr_read<v_rd_off(D0, 1, 1)>(vb);
  const s16x4 l2 = tr_read<v_rd_off(D0, 2, 0)>(vb), h2 = tr_read<v_rd_off(D0, 2, 1)>(vb), l3 = tr_read<v_rd_off(D0, 3, 0)>(vb), h3 = tr_read<v_rd_off(D0, 3, 1)>(vb);
  asm volatile("s_waitcnt lgkmcnt(0)" ::: "memory"); SBAR();
#define PK(L, H) (bf16x8){L[0], L[1], L[2], L[3], H[0], H[1], H[2], H[3]}
  od = __builtin_amdgcn_mfma_f32_32x32x16_bf16(pa0, PK(l0, h0), od, 0, 0, 0);
  od = __builtin_amdgcn_mfma_f32_32x32x16_bf16(pa1, PK(l1, h1), od, 0, 0, 0);
  od = __builtin_amdgcn_mfma_f32_32x32x16_bf16(pa2, PK(l2, h2), od, 0, 0, 0);
  od = __builtin_amdgcn_mfma_f32_32x32x16_bf16(pa3, PK(l3, h3), od, 0, 0, 0);
#undef PK
}
__device__ __forceinline__ void pv_d0(f32x16* o, int vb, bf16x8 pa0, bf16x8 pa1, bf16x8 pa2, bf16x8 pa3) {
  pv_one<0>(o[0], vb, pa0, pa1, pa2, pa3); pv_one<1>(o[1], vb, pa0, pa1, pa2, pa3); pv_one<2>(o[2], vb, pa0, pa1, pa2, pa3); pv_one<3>(o[3], vb, pa0, pa1, pa2, pa3);
}
__device__ __forceinline__ void attn_unit(const bf16* __restrict__ Qb, const bf16* __restrict__ Kh, const bf16* __restrict__ Vh, const bf16* __restrict__ Gb, bf16* __restrict__ Yb, int seq, char* lds,
                                          const float* __restrict__ ropetab, const float* __restrict__ qnw, int t0) {
  int tid_ = threadIdx.x; asm volatile("" : "+v"(tid_));
  const int tid = tid_, wid = tid >> 6, lane = tid & 63, r32 = lane & 31, hi = lane >> 5;
  bf16* V_lds = (bf16*)lds; bf16* K_lds = (bf16*)(lds + 2 * SHM_V);
  float* ws = (float*)(lds + 2 * SHM_V + 2 * SHM_K) + wid * 64; float* li_l = ws; float* al_l = ws + 32;
  float m_reg = -1e30f, l_reg = 0; f32x16 o[4] = {}; bf16x8 qr[8];
  const bf16* Qw = Qb + (long)(wid * QBLK + r32) * LDQ + hi * 8;
  {
    bf16x8 raw[8]; float ss = 0.f;
#pragma unroll
    for (int d0 = 0; d0 < 8; ++d0) raw[d0] = ld8(Qw + d0 * 16);
#pragma unroll
    for (int d0 = 0; d0 < 8; ++d0)
#pragma unroll
      for (int j = 0; j < 8; ++j) { const float v = __uint_as_float((unsigned)(unsigned short)raw[d0][j] << 16); ss += v * v; }
    { auto rr = __builtin_amdgcn_permlane32_swap(__float_as_uint(ss), __float_as_uint(ss), false, false); ss = __uint_as_float(rr[0]) + __uint_as_float(rr[1]); }
    const float rstd = 1.0f / sqrtf(ss * (1.0f / D) + 1e-6f);
    const int tq = t0 + wid * QBLK + r32;
#pragma unroll
    for (int ax = 0; ax < 2; ++ax) {
      const float* cp = ropetab + (ax ? 32 + (tq & 63) : (tq >> 6)) * 32 + 8 * hi; const float* sp = cp + 96 * 32;
#pragma unroll
      for (int pb = 0; pb < 2; ++pb) {
        const int da = 4 * ax + pb, db = da + 2;
        const float4 c0 = *(const float4*)(cp + 16 * pb), c1 = *(const float4*)(cp + 16 * pb + 4), s0 = *(const float4*)(sp + 16 * pb), s1 = *(const float4*)(sp + 16 * pb + 4);
        const float4 wa0 = *(const float4*)(qnw + 16 * da + 8 * hi), wa1 = *(const float4*)(qnw + 16 * da + 8 * hi + 4), wb0 = *(const float4*)(qnw + 16 * db + 8 * hi), wb1 = *(const float4*)(qnw + 16 * db + 8 * hi + 4);
        const float cc[8] = {c0.x, c0.y, c0.z, c0.w, c1.x, c1.y, c1.z, c1.w}, sn[8] = {s0.x, s0.y, s0.z, s0.w, s1.x, s1.y, s1.z, s1.w};
        const float wa[8] = {wa0.x, wa0.y, wa0.z, wa0.w, wa1.x, wa1.y, wa1.z, wa1.w}, wb[8] = {wb0.x, wb0.y, wb0.z, wb0.w, wb1.x, wb1.y, wb1.z, wb1.w};
        float oa[8], ob[8];
#pragma unroll
        for (int j = 0; j < 8; ++j) { const float a = __uint_as_float((unsigned)(unsigned short)raw[da][j] << 16) * rstd * wa[j], b = __uint_as_float((unsigned)(unsigned short)raw[db][j] << 16) * rstd * wb[j];
          oa[j] = a * cc[j] - b * sn[j]; ob[j] = b * cc[j] + a * sn[j]; }
        u32x4 pa = {cvtpk(oa[0], oa[1]), cvtpk(oa[2], oa[3]), cvtpk(oa[4], oa[5]), cvtpk(oa[6], oa[7])}, pbk = {cvtpk(ob[0], ob[1]), cvtpk(ob[2], ob[3]), cvtpk(ob[4], ob[5]), cvtpk(ob[6], ob[7])};
        qr[da] = *reinterpret_cast<bf16x8*>(&pa); qr[db] = *reinterpret_cast<bf16x8*>(&pbk);
      }
    }
  }
  const int sr = tid >> 4, sc = (tid & 15) * 8, vst0 = v_st(sr, sc), vst1 = v_st(32 + sr, sc);
  const int vb0 = (int)(uintptr_t)V_lds + v_rd_base(lane);
  struct { bf16x8 vs0, vs1, ks0, ks1; } sr_[SDEPTH];
#define SLOAD(i, k0) do { sr_[i].vs0 = ld8(&Vh[(long)((k0) + sr) * LDK + sc]); sr_[i].vs1 = ld8(&Vh[(long)((k0) + 32 + sr) * LDK + sc]); \
    sr_[i].ks0 = ld8(&Kh[(long)((k0) + sr) * LDK + sc]); sr_[i].ks1 = ld8(&Kh[(long)((k0) + 32 + sr) * LDK + sc]); } while (0)
#define SWRITE(b, i) do { *(bf16x8*)((char*)V_lds + (b) * SHM_V + vst0) = sr_[i].vs0;          \
    *(bf16x8*)((char*)V_lds + (b) * SHM_V + vst1) = sr_[i].vs1; int kc = sc * 2;               \
    *(bf16x8*)((char*)K_lds + (b) * SHM_K + KSWZ(sr, kc)) = sr_[i].ks0;                       \
    *(bf16x8*)((char*)K_lds + (b) * SHM_K + KSWZ(32 + sr, kc)) = sr_[i].ks1; } while (0)
#define SWAIT() do { if constexpr (SDEPTH == 2) asm volatile("s_waitcnt vmcnt(4)" ::: "memory"); else asm volatile("s_waitcnt vmcnt(0)" ::: "memory"); } while (0)
#define RESC(a) do { if (__any((a) < 1.f)) { if (hi == 0) al_l[r32] = (a); asm volatile("s_waitcnt lgkmcnt(0)" ::: "memory"); \
    for (int d = 0; d < 4; ++d) for (int r = 0; r < 16; ++r) o[d][r] *= al_l[crow(r, hi)]; } } while (0)
  f32x16 pA0, pA1, pB0, pB1; float mnA, mnB, alA, alB; bf16x8 pa0, pa1, pa2, pa3; const int NT = seq / KVBLK;
  constexpr int SE = 0, SO = SDEPTH - 1;
  SLOAD(SE, 0); asm volatile("s_waitcnt vmcnt(0)" ::: "memory"); SWRITE(0, SE); __syncthreads();
  qkt(pA0, pA1, K_lds, qr, r32, hi); partialSM(pA0, pA1, m_reg, mnA, alA);
  SLOAD(SO, KVBLK); if constexpr (SDEPTH == 2) { if (2 < NT) SLOAD(SE, 2 * KVBLK); }
  SWAIT(); SWRITE(1, SO); __syncthreads();
  for (int j = 1; j + 1 < NT; j += 2) {
    SBAR(); qkt(pB0, pB1, (bf16*)((char*)K_lds + SHM_K), qr, r32, hi);
    finishSM(pA0, pA1, alA, l_reg, pa0, pa1, pa2, pa3); SBAR();
    SLOAD(SO, (j + SDEPTH) * KVBLK); SBAR();
    pv_d0(o, vb0, pa0, pa1, pa2, pa3); partialSM(pB0, pB1, m_reg, mnB, alB);
    __syncthreads(); SWAIT(); SWRITE(0, SE);
    RESC(alB); __syncthreads();
    SBAR(); qkt(pA0, pA1, K_lds, qr, r32, hi);
    finishSM(pB0, pB1, alB, l_reg, pa0, pa1, pa2, pa3); SBAR();
    if (SDEPTH == 1 || j + 3 < NT) SLOAD(SE, (j + 1 + SDEPTH) * KVBLK); SBAR();
    pv_d0(o, vb0 + (int)SHM_V, pa0, pa1, pa2, pa3); partialSM(pA0, pA1, m_reg, mnA, alA);
    __syncthreads(); SWAIT(); SWRITE(1, SO);
    RESC(alA); __syncthreads();
  }
  SBAR(); qkt(pB0, pB1, (bf16*)((char*)K_lds + SHM_K), qr, r32, hi);
  finishSM(pA0, pA1, alA, l_reg, pa0, pa1, pa2, pa3); SBAR();
  pv_d0(o, vb0, pa0, pa1, pa2, pa3); partialSM(pB0, pB1, m_reg, mnB, alB);
  __syncthreads(); RESC(alB);
  finishSM(pB0, pB1, alB, l_reg, pa0, pa1, pa2, pa3); SBAR();
  pv_d0(o, vb0 + (int)SHM_V, pa0, pa1, pa2, pa3);
  if (hi == 0) li_l[r32] = l_reg; asm volatile("s_waitcnt lgkmcnt(0)" ::: "memory");
  float rli[16];
#pragma unroll
  for (int r = 0; r < 16; ++r) rli[r] = __builtin_amdgcn_rcpf(li_l[crow(r, hi)]);
  unsigned short* ost = (unsigned short*)(lds + SHM_ATTN) + wid * (QBLK * D);
#pragma unroll
  for (int r = 0; r < 16; ++r) { const int orow = crow(r, hi);
#pragma unroll
    for (int d0 = 0; d0 < 4; ++d0) ost[orow * D + d0 * 32 + r32] = (unsigned short)(cvtpk(o[d0][r] * rli[r], 0.f) & 0xffffu); }
  asm volatile("s_waitcnt lgkmcnt(0)" ::: "memory");
  const unsigned short* Gw = (const unsigned short*)Gb + (long)(wid * QBLK) * LDO; unsigned short* Yw = (unsigned short*)Yb + (long)(wid * QBLK) * 64;
#pragma unroll
  for (int hf = 0; hf < 2; ++hf) { u32x4 gv[4], ov[4];
#pragma unroll
    for (int i = 0; i < 4; ++i) { const int c = lane + 64 * (4 * hf + i), row = c >> 4, ch = c & 15; gv[i] = *(const u32x4*)(Gw + (long)row * LDO + ch * 8); ov[i] = *(const u32x4*)(ost + row * D + ch * 8); }
#pragma unroll
    for (int i = 0; i < 4; ++i) { const int c = lane + 64 * (4 * hf + i), row = c >> 4, ch = c & 15; u32x4 y;
#pragma unroll
      for (int q = 0; q < 4; ++q) { const float ga = __uint_as_float(gv[i][q] << 16), gb = __uint_as_float(gv[i][q] & 0xffff0000u);
        const float sa = ga * __builtin_amdgcn_rcpf(1.0f + __builtin_amdgcn_exp2f(-1.4426950408889634f * ga)), sb = gb * __builtin_amdgcn_rcpf(1.0f + __builtin_amdgcn_exp2f(-1.4426950408889634f * gb));
        y[q] = cvtpk(__uint_as_float(ov[i][q] << 16) * sa, __uint_as_float(ov[i][q] & 0xffff0000u) * sb); }
      *(u32x4*)(Yw + (long)row * 64 + (ch >> 3) * (256 * 64) + (ch & 7) * 8) = y; }
    asm volatile("" ::: "memory"); }
#undef SLOAD
#undef SWRITE
#undef SWAIT
#undef RESC
}
#undef KSWZ
#undef SBAR
}
constexpr int NWAVES = 8;
#ifndef MK_N_LAUNCHES
#define MK_N_LAUNCHES 1
#endif
constexpr int N_PHASES = 11;
constexpr int N_LAUNCHES = MK_N_LAUNCHES;
static_assert(N_LAUNCHES == 1 || N_LAUNCHES == N_PHASES, "MK_N_LAUNCHES is 1 or N_PHASES");
constexpr int RING_OFF = 0, RING_BYTES = 131072;
constexpr int LDSCTL_OFF = 143360, MISC_OFF = LDSCTL_OFF + 320;
constexpr int LDS_BYTES = 147456;
static_assert(MISC_OFF + 128 <= LDS_BYTES && (int)attn::SHM_TOTAL <= LDSCTL_OFF, "LDS map");

#define GAS __attribute__((address_space(1)))
#define LAS __attribute__((address_space(3)))
typedef unsigned short bf16;
typedef unsigned v4u __attribute__((ext_vector_type(4)));
typedef unsigned v2u __attribute__((ext_vector_type(2)));
typedef float f32x4 __attribute__((ext_vector_type(4)));
typedef GAS unsigned gu32;
#define RLX_AGENT __ATOMIC_RELAXED, __HIP_MEMORY_SCOPE_AGENT
#define LDS_WAIT() asm volatile("s_waitcnt lgkmcnt(0)" ::: "memory")
#define VM_WAIT() asm volatile("s_waitcnt vmcnt(0)" ::: "memory")
__device__ __forceinline__ unsigned f2bf(float f) { unsigned u = __builtin_bit_cast(unsigned, f); return (u + 0x7fffu + ((u >> 16) & 1u)) >> 16; }
__device__ __forceinline__ unsigned pk2(float lo, float hi) { typedef float f32x2_ __attribute__((ext_vector_type(2))); typedef __bf16 bf16x2_ __attribute__((ext_vector_type(2))); f32x2_ v = {lo, hi}; return __builtin_bit_cast(unsigned, __builtin_convertvector(v, bf16x2_)); }
__device__ __forceinline__ float bflo(unsigned w) { return __uint_as_float(w << 16); }
__device__ __forceinline__ float bfhi(unsigned w) { return __uint_as_float(w & 0xffff0000u); }
#define XB_TMO      128
#define XB_XCNT(j)  (256  + 64 * (j))
#define XB_XSUB(j)  (1280 + 64 * (j))
#define XB_XGEN(j)  (2304 + 64 * (j))
#define XB_TOP      3328
#define XB_TOPGEN   3392
#define XCD_BAR_WORDS 3456
#define XB_SPIN_CAP (1u << 18)

__device__ __forceinline__ unsigned xb_ld(unsigned* p)              { return __hip_atomic_load(p, __ATOMIC_RELAXED, __HIP_MEMORY_SCOPE_AGENT); }
__device__ __forceinline__ unsigned xb_add(unsigned* p, unsigned v) { return __hip_atomic_fetch_add(p, v, __ATOMIC_RELAXED, __HIP_MEMORY_SCOPE_AGENT); }
__device__ __forceinline__ unsigned xb_xcc_id() { return (unsigned)__builtin_amdgcn_s_getreg((3 << 11) | 20) & 0xFu; }
#define XB_SPIN(cond, bar) do { unsigned _sp = 0; while (cond) { __builtin_amdgcn_s_sleep(1); \
    if ((++_sp & 255u) == 0u) { if (xb_ld(&(bar)[XB_TMO])) break; if (_sp > XB_SPIN_CAP) { atomicAdd(&(bar)[XB_TMO], 1u); break; } } } } while (0)

struct XcdBarrier {
    unsigned* bar; unsigned x;
    volatile LAS unsigned* st;
};

__device__ __forceinline__ XcdBarrier xcd_barrier_post(unsigned* bar, volatile LAS unsigned* st) {
    XcdBarrier b; b.bar = bar; b.x = xb_xcc_id(); b.st = st;
    if (threadIdx.x == 0) (void)xb_add(&bar[XB_XCNT(b.x)], 1u);
    return b;
}
__device__ __forceinline__ void xcd_barrier_complete(unsigned* bar, unsigned x, unsigned& nloc, unsigned& nx) {
    const unsigned G = gridDim.x * gridDim.y * gridDim.z;
    unsigned sum, cnt, mine, sp = 0u;
    for (;;) {
        sum = 0u; cnt = 0u; mine = 0u;
#pragma unroll
        for (unsigned j = 0; j < 16; ++j) { const unsigned c = xb_ld(&bar[XB_XCNT(j)]); sum += c; cnt += (c > 0u) ? 1u : 0u; mine = (j == x) ? c : mine; }
        if (sum == G) break;
        __builtin_amdgcn_s_sleep(1);
        if ((++sp & 255u) == 0u) { if (xb_ld(&bar[XB_TMO])) break; if (sp > XB_SPIN_CAP) { atomicAdd(&bar[XB_TMO], 1u); break; } }
    }
    nloc = mine > 0u ? mine : 1u; nx = cnt > 0u ? cnt : 1u;
}

__device__ __forceinline__ void xcd_barrier(const XcdBarrier& b) {
    asm volatile("s_waitcnt vmcnt(0)" ::: "memory");
    __syncthreads();
    if (threadIdx.x == 0) {
        unsigned* bar = b.bar;
        __builtin_amdgcn_s_waitcnt(0);
        unsigned nloc = b.st[0], nx = b.st[1];
        if (nloc == 0u) { xcd_barrier_complete(bar, b.x, nloc, nx); b.st[0] = nloc; b.st[1] = nx; }
        const unsigned old = xb_add(&bar[XB_XSUB(b.x)], 1u);
        const unsigned gen = old / nloc;
        if (old + 1u == (gen + 1u) * nloc) {
            __builtin_amdgcn_fence(__ATOMIC_RELEASE, "agent");
            asm volatile("s_waitcnt vmcnt(0)" ::: "memory");
            const unsigned og = xb_add(&bar[XB_TOP], 1u);
            const unsigned tg = og / nx;
            if (og + 1u == (tg + 1u) * nx) xb_add(&bar[XB_TOPGEN], 1u);
            else XB_SPIN(xb_ld(&bar[XB_TOPGEN]) == tg, bar);
            __builtin_amdgcn_fence(__ATOMIC_ACQUIRE, "agent");
            xb_add(&bar[XB_XGEN(b.x)], 1u);
            asm volatile("s_waitcnt vmcnt(0)" ::: "memory");
        } else {
            XB_SPIN(xb_ld(&bar[XB_XGEN(b.x)]) == gen, bar);
            __builtin_amdgcn_fence(__ATOMIC_ACQUIRE, "agent");
            asm volatile("s_waitcnt vmcnt(0)" ::: "memory");
        }
    }
    __syncthreads();
}
struct Frame {
    LAS unsigned char* lds;
    volatile LAS unsigned* MISC;
    gu32* ctl;
    int tid, lane, wave;
    int vcu, G;
    const float *x, *c, *ctx, *c_ctx, *norm_w, *w_ada, *b_ada, *w_in, *q_norm_w, *k_norm_w, *lb_logits, *hg_norm_w, *w_proj_hg, *w_proj_att, *w_out, *final_norm_w;
    float* out; unsigned char* ws;
};
__device__ __forceinline__ float wave_sum(float v) {
#pragma unroll
    for (int o = 1; o < 64; o <<= 1) v += __shfl_xor(v, o);
    return v;
}
__device__ __forceinline__ float sum16(float v) {
    v += __shfl_xor(v, 1); v += __shfl_xor(v, 2); v += __shfl_xor(v, 4); v += __shfl_xor(v, 8); return v;
}
__device__ __forceinline__ float sigmoid_acc(float v) { return 1.0f / (1.0f + expf(-v)); }
__device__ __forceinline__ void sincos_d(double x, double& s, double& c) {
    const double n = rint(x * 0.63661977236758134308);
    double r = fma(-n, 1.5707963267948966192, x); r = fma(-n, 6.123233995736766036e-17, r);
    const double r2 = r * r;
    double ps = -1.0 / 355687428096000.0;
    ps = fma(ps, r2, 1.0 / 1307674368000.0); ps = fma(ps, r2, -1.0 / 6227020800.0); ps = fma(ps, r2, 1.0 / 39916800.0); ps = fma(ps, r2, -1.0 / 362880.0);
    ps = fma(ps, r2, 1.0 / 5040.0); ps = fma(ps, r2, -1.0 / 120.0); ps = fma(ps, r2, 1.0 / 6.0); ps = -ps;
    const double sr = fma(r * r2, ps, r);
    double pc = 1.0 / 20922789888000.0;
    pc = fma(pc, r2, -1.0 / 87178291200.0); pc = fma(pc, r2, 1.0 / 479001600.0); pc = fma(pc, r2, -1.0 / 3628800.0); pc = fma(pc, r2, 1.0 / 40320.0);
    pc = fma(pc, r2, -1.0 / 720.0); pc = fma(pc, r2, 1.0 / 24.0); pc = fma(pc, r2, -0.5);
    const double cr = fma(pc, r2, 1.0);
    const int q = ((int)n) & 3;
    s = (q == 0) ? sr : (q == 1) ? cr : (q == 2) ? -sr : -cr;
    c = (q == 0) ? cr : (q == 1) ? -sr : (q == 2) ? -cr : sr;
}
constexpr int ADA_ITEMS = 4 * (NADA / 32);
__device__ __forceinline__ void p0_prologue(Frame& F) {
    const int gw = F.vcu * NWAVES + F.wave, NGW = F.G * NWAVES;
    float* tab = (float*)(F.ws + WS_TAB);
    if (F.vcu == F.G - 1) {
        for (int i = F.tid; i < 96 * 32; i += NWAVES * 64) { const int p = i >> 5, f = i & 31; const double pos = (double)(p < 32 ? p : p - 32);
            const double inv = exp(-(double)f * (9.2103403719761836 / 32.0));
            double s, c; sincos_d(pos * inv, s, c); tab[i] = (float)c; tab[96 * 32 + i] = (float)s; }
        float* lb = (float*)(F.ws + WS_TAB + TAB_LB);
        for (int i = F.tid; i < 2 * DM; i += NWAVES * 64) { const int d = i >> 12, k = i & 4095; const float a0 = F.lb_logits[(d * 2 + 0) * DM + k], a1 = F.lb_logits[(d * 2 + 1) * DM + k];
            lb[i] = 1.0f / (1.0f + expf(a1 - a0)); }
    }
    if (gw - F.wave < ADA_ITEMS) {
        LAS float* sl = (LAS float*)(F.lds + RING_OFF);
        for (int i = F.tid; i < 5 * DM; i += NWAVES * 64) { const float v = i < 4 * DM ? F.c[i] : F.c_ctx[i - 4 * DM]; sl[i] = v * sigmoid_acc(v); }
        __syncthreads();
        float* slab = (float*)(F.ws + WS_MODP);
        for (int item = gw; item < ADA_ITEMS; item += NGW) {
            const int kq = item / (NADA / 32), n0 = (item % (NADA / 32)) * 32, rq = F.lane >> 3, cq = F.lane & 7, kbase = kq * 1024;
            f32x4 acc[5];
#pragma unroll
            for (int b = 0; b < 5; ++b) acc[b] = (f32x4){0.f, 0.f, 0.f, 0.f};
            const float* wp = F.w_ada + (size_t)(kbase + rq) * NADA + n0 + 4 * cq;
            for (int it = 0; it < 128; it += 8) {
                f32x4 w[8];
#pragma unroll
                for (int u = 0; u < 8; ++u) w[u] = __builtin_nontemporal_load((const f32x4*)(wp + (size_t)(it + u) * 8 * NADA));
#pragma unroll
                for (int u = 0; u < 8; ++u) { const int k = kbase + (it + u) * 8 + rq;
#pragma unroll
                    for (int b = 0; b < 5; ++b) acc[b] += sl[b * DM + k] * w[u]; }
            }
#pragma unroll
            for (int b = 0; b < 5; ++b)
#pragma unroll
                for (int j = 0; j < 4; ++j) { float v = acc[b][j]; v += __shfl_xor(v, 8); v += __shfl_xor(v, 16); v += __shfl_xor(v, 32); acc[b][j] = v; }
            if (rq == 0) {
#pragma unroll
                for (int b = 0; b < 5; ++b) *(f32x4*)(slab + ((size_t)kq * 5 + b) * NADA + n0 + 4 * cq) = acc[b]; }
        }
        __syncthreads();
    }
}
__device__ __forceinline__ void p1_modulate(Frame& F) {
    const float* slab = (const float*)(F.ws + WS_MODP);
    if (F.vcu < 32) {
        const int idx = F.vcu * 512 + F.tid, b = idx >> 12, c = idx & 4095; float g = F.b_ada[2 * DM + c];
#pragma unroll
        for (int s = 0; s < 4; ++s) g += slab[((size_t)s * 5 + b) * NADA + 2 * DM + c];
        ((float*)(F.ws + WS_TAB + TAB_GATE))[idx] = g;
    }
    LAS float* cA = (LAS float*)(F.lds + RING_OFF); LAS float* cS = cA + DM;
    const int r_lo = (int)((long)F.vcu * MH / F.G), r_hi = (int)((long)(F.vcu + 1) * MH / F.G);
    int seg_lo = r_lo;
    while (seg_lo < r_hi) {
        const int bid = seg_lo < MX ? seg_lo / T : 4;
        const int bend = bid < 4 ? (bid + 1) * T : MH;
        const int seg_hi = r_hi < bend ? r_hi : bend;
        __syncthreads();
        for (int k = F.tid; k < DM; k += NWAVES * 64) { float sh = F.b_ada[k], sc = F.b_ada[DM + k];
#pragma unroll
            for (int s = 0; s < 4; ++s) { sh += slab[((size_t)s * 5 + bid) * NADA + k]; sc += slab[((size_t)s * 5 + bid) * NADA + DM + k]; }
            cA[k] = F.norm_w[k] * (1.0f + sc); cS[k] = sh; }
        __syncthreads();
        for (int row = seg_lo + F.wave; row < seg_hi; row += NWAVES) {
            const float* xr = row < MX ? F.x + (size_t)row * DM : F.ctx + (size_t)(row - MX) * DM;
            const GAS f32x4* xp = (const GAS f32x4*)xr + F.lane;
            f32x4 v[16]; float ss = 0.f;
#pragma unroll
            for (int j = 0; j < 16; ++j) { v[j] = __builtin_nontemporal_load(xp + 64 * j); ss += (v[j].x * v[j].x + v[j].y * v[j].y) + (v[j].z * v[j].z + v[j].w * v[j].w); }
            const float rstd = 1.0f / sqrtf(wave_sum(ss) * (1.0f / DM) + EPS);
            GAS v2u* op = (GAS v2u*)((bf16*)(F.ws + WS_H) + (size_t)(row >> 8) * (DM / 64) * (256 * 64) + (row & 255) * 64 + (F.lane >> 4) * (256 * 64)) + (F.lane & 15);
#pragma unroll
            for (int j = 0; j < 16; ++j) { const f32x4 a = *(const LAS f32x4*)(cA + 4 * (64 * j + F.lane)), s = *(const LAS f32x4*)(cS + 4 * (64 * j + F.lane));
                const f32x4 h = v[j] * rstd * a + s; v2u o; o.x = pk2(h.x, h.y); o.y = pk2(h.z, h.w); *op = o; op += 4 * 256 * 64 / 4;
                if ((j & 3) == 3) asm volatile("" ::: "memory"); }
        }
        seg_lo = seg_hi;
    }
}
template <int N> __device__ __forceinline__ void conv_issue(const float* W, int item, int lane, f32x4 (&a)[16]) {
    const int kb = item / (N / 64), nb = item % (N / 64);
    const float* p = W + (size_t)(64 * kb + 2 * (lane >> 4)) * N + 64 * nb + 4 * (lane & 15);
#pragma unroll
    for (int i = 0; i < 16; ++i) { const float* q = p + (size_t)(8 * (i >> 1) + (i & 1)) * N; asm volatile("global_load_dwordx4 %0, %1, off nt" : "=v"(a[i]) : "v"(q)); }
}
#define CONV_OPS(X) "+v"(X[0]), "+v"(X[1]), "+v"(X[2]), "+v"(X[3]), "+v"(X[4]), "+v"(X[5]), "+v"(X[6]), "+v"(X[7]), "+v"(X[8]), "+v"(X[9]), "+v"(X[10]), "+v"(X[11]), "+v"(X[12]), "+v"(X[13]), "+v"(X[14]), "+v"(X[15])
__device__ __forceinline__ void conv_wait(f32x4 (&a)[16]) { asm volatile("s_waitcnt vmcnt(16)" : CONV_OPS(a) :: "memory"); }
__device__ __forceinline__ void conv_drain(f32x4 (&a)[16], f32x4 (&b)[16]) { asm volatile("s_waitcnt vmcnt(0)" : CONV_OPS(a) :: "memory"); asm volatile("" : CONV_OPS(b) :: "memory"); }
template <int N> __device__ __forceinline__ void conv_emit(bf16* WT, int item, int lane, LAS unsigned char* scr, const f32x4 (&a)[16]) {
    const int kb = item / (N / 64), nb = item % (N / 64), rg = lane >> 4, cn = lane & 15;
#pragma unroll
    for (int p_ = 0; p_ < 8; ++p_)
#pragma unroll
        for (int j = 0; j < 4; ++j) *(LAS unsigned*)(scr + (4 * cn + j) * 136 + (8 * p_ + 2 * rg) * 2) = pk2(a[2 * p_][j], a[2 * p_ + 1][j]);
    LDS_WAIT(); asm volatile("" ::: "memory");
    bf16* dst = WT + ((size_t)(nb >> 2) * (DM / 64) + kb) * (256 * 64) + (nb & 3) * (64 * 64) + lane * 8;
#pragma unroll
    for (int jj = 0; jj < 8; ++jj) { const LAS unsigned char* s_ = scr + (8 * jj + (lane >> 3)) * 136 + 16 * (lane & 7);
        const v2u lo = *(const LAS v2u*)s_, hi = *(const LAS v2u*)(s_ + 8); v4u o; o.x = lo.x; o.y = lo.y; o.z = hi.x; o.w = hi.y;
        *(GAS v4u*)(dst + jj * 512) = o; }
    LDS_WAIT(); asm volatile("" ::: "memory");
}
template <int N> __device__ __forceinline__ void conv_stream(const float* W, bf16* WT, int first, int step, int lane, LAS unsigned char* scr) {
    constexpr int NI = (DM / 64) * (N / 64);
    if (first >= NI) return;
    f32x4 A[16], B[16];
    int it = first; conv_issue<N>(W, it, lane, A);
    for (; it < NI; it += 2 * step) { const int i2 = it + step, i3 = it + 2 * step;
        conv_issue<N>(W, i2 < NI ? i2 : it, lane, B); conv_wait(A); conv_emit<N>(WT, it, lane, scr, A);
        conv_issue<N>(W, i3 < NI ? i3 : it, lane, A); conv_wait(B); if (i2 < NI) conv_emit<N>(WT, i2, lane, scr, B); }
    conv_drain(A, B);
}
__device__ __forceinline__ void p0c_convert(Frame& F) {
    const int gw = F.vcu * NWAVES + F.wave, NGW = F.G * NWAVES;
    __syncthreads();
    LAS unsigned char* scr = (LAS unsigned char*)(F.lds + RING_OFF + F.wave * 16384);
    conv_stream<NIN>(F.w_in, (bf16*)(F.ws + WS_WIN), gw, NGW, F.lane, scr);
    conv_stream<DM>(F.w_proj_hg, (bf16*)(F.ws + WS_WPH), gw, NGW, F.lane, scr);
    if (F.G != 256) { conv_stream<DM>(F.w_proj_att, (bf16*)(F.ws + WS_WPA), gw, NGW, F.lane, scr); conv_stream<DM>(F.w_out, (bf16*)(F.ws + WS_WO), gw, NGW, F.lane, scr); }
}
__device__ __forceinline__ void p2_tail_convert(Frame& F, int idx) {
    LAS unsigned char* scr = (LAS unsigned char*)(F.lds + RING_OFF + F.wave * 16384);
    conv_stream<DM>(F.w_proj_att, (bf16*)(F.ws + WS_WPA), idx * NWAVES + F.wave, 32 * NWAVES, F.lane, scr);
    conv_stream<DM>(F.w_out, (bf16*)(F.ws + WS_WO), idx * NWAVES + F.wave, 32 * NWAVES, F.lane, scr);
}
__device__ __forceinline__ void p3_qk_norm_rope(Frame& F) {
    const int gw = F.vcu * NWAVES + F.wave, NGW = F.G * NWAVES;
    const float* tab = (const float*)(F.ws + WS_TAB);
    const int e = F.lane & 15, hl = F.lane >> 4;
    for (int it = gw; it < BATCH * NKV * (SKV / 4); it += NGW) {
        const int bh = it / (SKV / 4), pos = (it % (SKV / 4)) * 4 + hl, t = pos - LCTX;
        bf16* p = (bf16*)(F.ws + WS_KALL) + ((size_t)bh * SKV + pos) * HD + 8 * e; const float* w = F.k_norm_w;
        const v4u raw = *(const GAS v4u*)p;
        float y[8] = {bflo(raw.x), bfhi(raw.x), bflo(raw.y), bfhi(raw.y), bflo(raw.z), bfhi(raw.z), bflo(raw.w), bfhi(raw.w)};
        float ss = 0.f;
#pragma unroll
        for (int j = 0; j < 8; ++j) ss += y[j] * y[j];
        const float rstd = 1.0f / sqrtf(sum16(ss) * (1.0f / HD) + EPS);
        const f32x4 w0 = *(const f32x4*)(w + 8 * e), w1 = *(const f32x4*)(w + 8 * e + 4);
#pragma unroll
        for (int j = 0; j < 8; ++j) y[j] = y[j] * rstd * (j < 4 ? w0[j] : w1[j - 4]);
        if (t >= 0) {
            const int posi = (e >> 3) ? 32 + (t & 63) : (t >> 6);
            const float* cp = tab + posi * 32 + 8 * (e & 3); const float* sp = cp + 96 * 32;
            const f32x4 c0 = *(const f32x4*)cp, c1 = *(const f32x4*)(cp + 4), s0 = *(const f32x4*)sp, s1 = *(const f32x4*)(sp + 4);
            const float sgn = ((e >> 2) & 1) ? 1.0f : -1.0f;
#pragma unroll
            for (int j = 0; j < 8; ++j) { const float pr = __shfl_xor(y[j], 4); const float cc = j < 4 ? c0[j] : c1[j - 4], sn = j < 4 ? s0[j] : s1[j - 4]; y[j] = y[j] * cc + sgn * pr * sn; }
        }
        v4u o; o.x = pk2(y[0], y[1]); o.y = pk2(y[2], y[3]); o.z = pk2(y[4], y[5]); o.w = pk2(y[6], y[7]);
        *(GAS v4u*)p = o;
    }
}
__device__ __forceinline__ int hg_posof(int n, int i, int dir) {
    if (n < 8) { const int pos = 32 * n + i; return dir ? LCTX - 1 - pos : pos; }
    const int pos = 32 * (n - 8) + i; return LCTX + (dir ? T - 1 - pos : pos);
}
__device__ __forceinline__ void p5_attention(Frame& F) {
    const attn::bf16* Q = (const attn::bf16*)(F.ws + WS_QATT); const attn::bf16* K = (const attn::bf16*)(F.ws + WS_KALL); const attn::bf16* V = (const attn::bf16*)(F.ws + WS_VALL);
    const attn::bf16* Gt = (const attn::bf16*)(F.ws + WS_GATT); attn::bf16* Y = (attn::bf16*)(F.ws + WS_YATT);
    for (int u = F.vcu; u < BATCH * NH * (T / 256); u += F.G) {
        const int grp = u >> 5, j = u & 31, b = grp >> 3, kvh = grp & 7, h = kvh * 4 + (j >> 3), qb = j & 7;
        const size_t qo = ((size_t)(b * NH + h) * T + qb * 256) * HD, ko = (size_t)(b * NKV + kvh) * SKV * HD;
        attn::attn_unit(Q + qo, K + ko, V + ko, Gt + qo, Y + tm_off(b * T + qb * 256, h * HD), SKV, (char*)(F.lds + RING_OFF), (const float*)(F.ws + WS_TAB), F.q_norm_w, qb * 256);
    }
}
__device__ __forceinline__ void p6_hgrn_out(Frame& F) {
    const int gw = F.vcu * NWAVES + F.wave, NGW = F.G * NWAVES, e = F.lane & 15, tl = F.lane >> 4;
    typedef _Float16 f16x8 __attribute__((ext_vector_type(8)));
    const _Float16* Of = (const _Float16*)(F.ws + WS_OF); const _Float16* Ob = (const _Float16*)(F.ws + WS_OB); const bf16* Gh = (const bf16*)(F.ws + WS_GHG); bf16* Y = (bf16*)(F.ws + WS_YHG);
    for (int it = gw; it < BATCH * NH * (T / 4); it += NGW) {
        const int bh = it / (T / 4), t = (it % (T / 4)) * 4 + tl, b = bh >> 5, hh = bh & 31; const size_t o = ((size_t)bh * T + t) * HD + 8 * e;
        const f16x8 fa = __builtin_nontemporal_load((const f16x8*)(Of + o)), fb = __builtin_nontemporal_load((const f16x8*)(Ob + o));
        const f32x4 a0 = {(float)fa[0], (float)fa[1], (float)fa[2], (float)fa[3]}, a1 = {(float)fa[4], (float)fa[5], (float)fa[6], (float)fa[7]};
        const f32x4 b0 = {(float)fb[0], (float)fb[1], (float)fb[2], (float)fb[3]}, b1 = {(float)fb[4], (float)fb[5], (float)fb[6], (float)fb[7]};
        const v4u g = __builtin_nontemporal_load((const v4u*)(Gh + o)); const f32x4 w0 = *(const f32x4*)(F.hg_norm_w + hh * HD + 8 * e), w1 = *(const f32x4*)(F.hg_norm_w + hh * HD + 8 * e + 4);
        const f32x4 y0 = a0 + b0, y1 = a1 + b1;
        const float ss = (y0.x * y0.x + y0.y * y0.y) + (y0.z * y0.z + y0.w * y0.w) + (y1.x * y1.x + y1.y * y1.y) + (y1.z * y1.z + y1.w * y1.w);
        const float rstd = 1.0f / sqrtf(sum16(ss) * (1.0f / HD) + EPS);
        float gs[8] = {bflo(g.x), bfhi(g.x), bflo(g.y), bfhi(g.y), bflo(g.z), bfhi(g.z), bflo(g.w), bfhi(g.w)};
#pragma unroll
        for (int j = 0; j < 8; ++j) gs[j] = gs[j] * __builtin_amdgcn_rcpf(1.0f + __builtin_amdgcn_exp2f(-1.4426950408889634f * gs[j]));
        v4u r; r.x = pk2(y0.x * rstd * w0.x * gs[0], y0.y * rstd * w0.y * gs[1]); r.y = pk2(y0.z * rstd * w0.z * gs[2], y0.w * rstd * w0.w * gs[3]);
        r.z = pk2(y1.x * rstd * w1.x * gs[4], y1.y * rstd * w1.y * gs[5]); r.w = pk2(y1.z * rstd * w1.z * gs[6], y1.w * rstd * w1.w * gs[7]);
        *(v4u*)(Y + tm_off(b * T + t, hh * HD + 8 * e)) = r;
    }
}
__device__ __forceinline__ void p10_final_norm(Frame& F) {
    const int gw = F.vcu * NWAVES + F.wave, NGW = F.G * NWAVES;
    for (int row = gw; row < MX; row += NGW) {
        GAS f32x4* xp = (GAS f32x4*)(F.out + (size_t)row * DM) + F.lane;
        f32x4 v[16]; float ss = 0.f;
#pragma unroll
        for (int j = 0; j < 16; ++j) { v[j] = xp[64 * j]; ss += (v[j].x * v[j].x + v[j].y * v[j].y) + (v[j].z * v[j].z + v[j].w * v[j].w); }
        const float rstd = 1.0f / sqrtf(wave_sum(ss) * (1.0f / DM) + EPS);
#pragma unroll
        for (int j = 0; j < 16; ++j) { const f32x4 w = *((const f32x4*)F.final_norm_w + 64 * j + F.lane); xp[64 * j] = v[j] * rstd * w; }
    }
}
namespace hg {
typedef short bf16x8 __attribute__((ext_vector_type(8)));
typedef short s16x4 __attribute__((ext_vector_type(4)));
typedef short v4i16_t __attribute__((ext_vector_type(4)));
typedef float f32x16 __attribute__((ext_vector_type(16)));
typedef float f32x2 __attribute__((ext_vector_type(2)));
typedef __bf16 bf16x2_t __attribute__((ext_vector_type(2)));
typedef LAS const char* lds_cptr;
constexpr int QS = 264;
constexpr int OFF_QE = 0, OFF_KE = 32 * QS, OFF_KD = 2 * 32 * QS, OFF_V = OFF_KD + 8192, OFF_DEC = OFF_V + 8192, BUF = OFF_DEC + 512;
__device__ __forceinline__ unsigned cvtpk(float lo, float hi) { f32x2 v = {lo, hi}; bf16x2_t b = __builtin_convertvector(v, bf16x2_t); return __builtin_bit_cast(unsigned, b); }
template <int S_> __device__ __forceinline__ bf16x8 pack_step(const f32x16& x) {
    v4u p = {cvtpk(x[8 * S_], x[8 * S_ + 1]), cvtpk(x[8 * S_ + 2], x[8 * S_ + 3]), cvtpk(x[8 * S_ + 4], x[8 * S_ + 5]), cvtpk(x[8 * S_ + 6], x[8 * S_ + 7])};
    return __builtin_bit_cast(bf16x8, p);
}
__device__ __forceinline__ s16x4 trd(lds_cptr p) { return __builtin_bit_cast(s16x4, __builtin_amdgcn_ds_read_tr16_b64_v4i16((LAS v4i16_t*)p)); }
__device__ __forceinline__ s16x4 ld8(lds_cptr p) { return *(const LAS s16x4*)p; }
__device__ __forceinline__ bf16x8 cat(s16x4 a, s16x4 b) { return __builtin_shufflevector(a, b, 0, 1, 2, 3, 4, 5, 6, 7); }
#define HG_MFMA(a, b, c) __builtin_amdgcn_mfma_f32_32x32x16_bf16((a), (b), (c), 0, 0, 0)
typedef _Float16 f16x2 __attribute__((ext_vector_type(2)));
struct Raw { unsigned g[8]; unsigned q[8]; v4u v0, v1; };
struct Ctx { const _Float16* Gsrc; const bf16* Qsrc; const bf16* Vsrc; _Float16* Odst; int dir; LAS unsigned char* lds; int lane, wave; float lb0, lb1, om0, om1; };
#define HG_GLD32(dst, ptr, off) asm volatile("global_load_dword %0, %1, off offset:%2" : "=v"(dst) : "v"(ptr), "i"(off))
#define HG_GLD128(dst, ptr, off) asm volatile("global_load_dwordx4 %0, %1, off offset:%2" : "=v"(dst) : "v"(ptr), "i"(off))
template <int SGN> __device__ __forceinline__ void load_raw_dir(const Ctx& C, Raw& R, int n_) {
    const int n = n_ < 72 ? n_ : 71;
    const int pw = C.wave - 4, rg = C.lane >> 4, cp = C.lane & 15, tp = pw * 64 + C.lane;
    const int p0 = hg_posof(n, 0, SGN < 0);
    const int o = (p0 + SGN * 8 * rg) * HD + 32 * pw + 2 * cp;
    const _Float16* gp = C.Gsrc + o; const bf16* qp = C.Qsrc + (n >= 8 ? o - LCTX * HD : 8 * rg * HD + 32 * pw + 2 * cp);
#define HG_ROW(r) HG_GLD32(R.g[r], gp, SGN * 256 * (r)); HG_GLD32(R.q[r], qp, (SGN < 0 ? -256 : 256) * (r))
    HG_ROW(0); HG_ROW(1); HG_ROW(2); HG_ROW(3); HG_ROW(4); HG_ROW(5); HG_ROW(6); HG_ROW(7);
#undef HG_ROW
    const bf16* vp = C.Vsrc + (p0 + SGN * (tp >> 3)) * HD + 16 * (tp & 7); HG_GLD128(R.v0, vp, 0); HG_GLD128(R.v1, vp, 16);
}
__device__ __forceinline__ void load_raw(const Ctx& C, Raw& R, int n) { if (C.dir) load_raw_dir<-1>(C, R, n); else load_raw_dir<1>(C, R, n); }
__device__ __forceinline__ void wait_raw(Raw& R) {
    asm volatile("s_waitcnt vmcnt(18)" : "+v"(R.g[0]), "+v"(R.g[1]), "+v"(R.g[2]), "+v"(R.g[3]), "+v"(R.g[4]), "+v"(R.g[5]), "+v"(R.g[6]), "+v"(R.g[7]),
                 "+v"(R.q[0]), "+v"(R.q[1]), "+v"(R.q[2]), "+v"(R.q[3]), "+v"(R.q[4]), "+v"(R.q[5]), "+v"(R.q[6]), "+v"(R.q[7]), "+v"(R.v0), "+v"(R.v1));
}
__device__ __forceinline__ void emit_tiles(const Ctx& C, const Raw& R, int buf, bool lat) {
    const int pw = C.wave - 4, rg = C.lane >> 4, cp = C.lane & 15, tp = pw * 64 + C.lane;
    LAS unsigned char* bb = C.lds + buf * BUF;
    float g0[8], g1[8], f0a[8], f1a[8], c0 = 1.f, c1 = 1.f;
#pragma unroll
    for (int r = 0; r < 8; ++r) { const f16x2 zz = __builtin_bit_cast(f16x2, R.g[r]);
        const float s0 = __builtin_amdgcn_rcpf(1.0f + __builtin_amdgcn_exp2f(-1.4426950408889634f * (float)zz.x)), s1 = __builtin_amdgcn_rcpf(1.0f + __builtin_amdgcn_exp2f(-1.4426950408889634f * (float)zz.y));
        const float f0 = C.lb0 + C.om0 * s0, f1 = C.lb1 + C.om1 * s1;
        c0 *= f0; c1 *= f1; g0[r] = c0; g1[r] = c1; f0a[r] = f0; f1a[r] = f1; }
    float base0, base1, tot0, tot1;
    { const auto a0 = __builtin_amdgcn_permlane16_swap(__float_as_uint(c0), __float_as_uint(c0), false, false), a1 = __builtin_amdgcn_permlane16_swap(__float_as_uint(c1), __float_as_uint(c1), false, false);
      const float p0 = __uint_as_float(a0[0] == __float_as_uint(c0) ? a0[1] : a0[0]), p1 = __uint_as_float(a1[0] == __float_as_uint(c1) ? a1[1] : a1[0]);
      const float s0 = c0 * p0, s1 = c1 * p1; base0 = (rg & 1) ? p0 : 1.f; base1 = (rg & 1) ? p1 : 1.f;
      const auto b0 = __builtin_amdgcn_permlane32_swap(__float_as_uint(s0), __float_as_uint(s0), false, false), b1 = __builtin_amdgcn_permlane32_swap(__float_as_uint(s1), __float_as_uint(s1), false, false);
      const float q0 = __uint_as_float(b0[0] == __float_as_uint(s0) ? b0[1] : b0[0]), q1 = __uint_as_float(b1[0] == __float_as_uint(s1) ? b1[1] : b1[0]);
      tot0 = s0 * q0; tot1 = s1 * q1; if (rg & 2) { base0 *= q0; base1 *= q1; } }
    const float eb0 = tot0, eb1 = tot1;
    float i0 = __builtin_amdgcn_rcpf(base0 * g0[7]), i1 = __builtin_amdgcn_rcpf(base1 * g1[7]);
#pragma unroll
    for (int r = 7; r >= 0; --r) { const int i = 8 * rg + r;
        const float e0 = base0 * g0[r], e1 = base1 * g1[r];
        const float ke0 = (1.0f - f0a[r]) * i0, ke1 = (1.0f - f1a[r]) * i1;
        const unsigned qq = lat ? R.q[r] : 0u;
        *(LAS unsigned*)(bb + OFF_QE + i * QS + (32 * pw + 2 * cp) * 2) = cvtpk(bflo(qq) * e0, bfhi(qq) * e1);
        *(LAS unsigned*)(bb + OFF_KE + i * QS + (32 * pw + 2 * cp) * 2) = cvtpk(ke0, ke1);
        *(LAS unsigned*)(bb + OFF_KD + pw * 2048 + i * 64 + 4 * cp) = cvtpk(ke0 * eb0, ke1 * eb1);
        i0 *= f0a[r]; i1 *= f1a[r]; }
    if (rg == 0) *(LAS f32x2*)(bb + OFF_DEC + (32 * pw + 2 * cp) * 4) = (f32x2){eb0, eb1};
    { const int row = tp >> 3, seg = tp & 7; LAS unsigned char* d = bb + OFF_V + (seg >> 1) * 2048 + row * 64 + (seg & 1) * 32; *(LAS v4u*)d = R.v0; *(LAS v4u*)(d + 16) = R.v1; }
}
__device__ __forceinline__ void consume(const Ctx& C, f32x16 (&S)[4], int n, int buf) {
    const int lane = C.lane, vb = C.wave, r = lane & 31, h = lane >> 5, g = (lane >> 4) & 1, q = (lane & 15) >> 2, p = lane & 3;
    lds_cptr bb = (lds_cptr)(C.lds + buf * BUF);
    lds_cptr trb = bb + (4 * h + q) * 64 + 32 * g + 8 * p;
    const bool lat = n >= 8;
    bf16x8 vf0, vf1;
    { lds_cptr vp = trb + OFF_V + vb * 2048; vf0 = cat(trd(vp), trd(vp + 8 * 64)); vf1 = cat(trd(vp + 16 * 64), trd(vp + 24 * 64)); }
    if (lat) {
        lds_cptr qp = bb + OFF_QE + r * QS + 8 * h, kp = bb + OFF_KE + r * QS + 8 * h;
        bf16x8 qf[8], kf[8];
#pragma unroll
        for (int f = 0; f < 8; ++f) { qf[f] = cat(ld8(qp + f * 32), ld8(qp + f * 32 + 16)); kf[f] = cat(ld8(kp + f * 32), ld8(kp + f * 32 + 16)); }
        __builtin_amdgcn_sched_barrier(0);
        f32x16 oacc, at;
#pragma unroll
        for (int i = 0; i < 16; ++i) { oacc[i] = 0.f; at[i] = 0.f; }
#pragma unroll
        for (int kb = 0; kb < 4; ++kb) {
            const bf16x8 s0 = pack_step<0>(S[kb]), s1 = pack_step<1>(S[kb]);
            oacc = HG_MFMA(qf[2 * kb], s0, oacc); at = HG_MFMA(kf[2 * kb], qf[2 * kb], at);
            oacc = HG_MFMA(qf[2 * kb + 1], s1, oacc); at = HG_MFMA(kf[2 * kb + 1], qf[2 * kb + 1], at);
        }
        __builtin_amdgcn_sched_barrier(0);
#pragma unroll
        for (int i = 0; i < 16; ++i) { const int j = (i & 3) + 8 * (i >> 2) + 4 * h; at[i] = j <= r ? at[i] : 0.f; }
        oacc = HG_MFMA(pack_step<0>(at), vf0, oacc); oacc = HG_MFMA(pack_step<1>(at), vf1, oacc);
        _Float16* op = C.Odst + (hg_posof(n, 4 * h, C.dir) - LCTX) * HD + 32 * vb + r;
        if (C.dir) {
#pragma unroll
            for (int i = 0; i < 16; ++i) op[-((i & 3) + 8 * (i >> 2)) * HD] = (_Float16)oacc[i];
        } else {
#pragma unroll
            for (int i = 0; i < 16; ++i) op[((i & 3) + 8 * (i >> 2)) * HD] = (_Float16)oacc[i];
        }
    }
    bf16x8 kd0[4], kd1[4];
#pragma unroll
    for (int kb = 0; kb < 4; ++kb) { lds_cptr kdp = trb + OFF_KD + kb * 2048; kd0[kb] = cat(trd(kdp), trd(kdp + 8 * 64)); kd1[kb] = cat(trd(kdp + 16 * 64), trd(kdp + 24 * 64)); }
    f32x4 dq[4];
    { lds_cptr dp = bb + OFF_DEC + (4 * h) * 4;
#pragma unroll
      for (int gq = 0; gq < 4; ++gq) dq[gq] = *(const LAS f32x4*)(dp + gq * 32); }
    __builtin_amdgcn_sched_barrier(0);
#pragma unroll
    for (int kb = 0; kb < 4; ++kb) {
        f32x4 dn[4];
        if (kb < 3) { lds_cptr dp = bb + OFF_DEC + (32 * (kb + 1) + 4 * h) * 4;
#pragma unroll
            for (int gq = 0; gq < 4; ++gq) dn[gq] = *(const LAS f32x4*)(dp + gq * 32); }
#pragma unroll
        for (int gq = 0; gq < 4; ++gq)
#pragma unroll
            for (int j = 0; j < 4; ++j) S[kb][4 * gq + j] *= dq[gq][j];
        S[kb] = HG_MFMA(kd0[kb], vf0, S[kb]); S[kb] = HG_MFMA(kd1[kb], vf1, S[kb]);
        if (kb < 3) {
#pragma unroll
            for (int gq = 0; gq < 4; ++gq) dq[gq] = dn[gq]; }
    }
}
#define HG_RAW_OPS(R) "+v"(R.g[0]), "+v"(R.g[1]), "+v"(R.g[2]), "+v"(R.g[3]), "+v"(R.g[4]), "+v"(R.g[5]), "+v"(R.g[6]), "+v"(R.g[7]), "+v"(R.q[0]), "+v"(R.q[1]), "+v"(R.q[2]), "+v"(R.q[3]), "+v"(R.q[4]), "+v"(R.q[5]), "+v"(R.q[6]), "+v"(R.q[7]), "+v"(R.v0), "+v"(R.v1)
__device__ __forceinline__ void drain_raw(Raw& A, Raw& B, Raw& C_) {
    asm volatile("s_waitcnt vmcnt(0)" : HG_RAW_OPS(A) :: "memory"); asm volatile("" : HG_RAW_OPS(B) :: "memory"); asm volatile("" : HG_RAW_OPS(C_) :: "memory");
}
#define HG_BAR() do { asm volatile("s_waitcnt lgkmcnt(0)" ::: "memory"); __builtin_amdgcn_s_barrier(); asm volatile("" ::: "memory"); } while (0)
__device__ __forceinline__ void phase(Frame& F) {
    for (int s = F.vcu; s < 2 * BATCH * NH; s += F.G) {
        Ctx C; C.dir = s & 1; C.lds = F.lds + RING_OFF; C.lane = F.lane; C.wave = F.wave;
        { const int bh = s >> 1;
          C.Gsrc = (const _Float16*)(F.ws + (C.dir ? WS_FB : WS_FF)) + (size_t)bh * SKV * HD; C.Vsrc = (const bf16*)(F.ws + WS_VHG) + (size_t)bh * SKV * HD;
          C.Qsrc = (const bf16*)(F.ws + WS_QHG) + (size_t)bh * T * HD; C.Odst = (_Float16*)(F.ws + (C.dir ? WS_OB : WS_OF)) + (size_t)bh * T * HD;
          const f32x2 lbv = *(const f32x2*)((const float*)(F.ws + WS_TAB + TAB_LB) + C.dir * DM + (bh & (NH - 1)) * HD + 32 * (F.wave & 3) + 2 * (F.lane & 15)); C.lb0 = lbv.x; C.lb1 = lbv.y; C.om0 = 1.0f - lbv.x; C.om1 = 1.0f - lbv.y; }
        if (F.wave >= 4) {
            Raw RA, RB, RC; load_raw(C, RA, 0); load_raw(C, RB, 1);
            for (int t = 0; t < 75; t += 3) {
                wait_raw(RA); load_raw(C, RC, t + 2); if (t < 72) emit_tiles(C, RA, t & 1, t >= 8);
                HG_BAR();
                wait_raw(RB); load_raw(C, RA, t + 3); if (t + 1 < 72) emit_tiles(C, RB, (t + 1) & 1, t + 1 >= 8);
                HG_BAR();
                wait_raw(RC); load_raw(C, RB, t + 4); if (t + 2 < 72) emit_tiles(C, RC, t & 1, t + 2 >= 8);
                HG_BAR();
            }
            drain_raw(RA, RB, RC);
        } else {
            f32x16 S[4];
#pragma unroll
            for (int kb = 0; kb < 4; ++kb)
#pragma unroll
                for (int i = 0; i < 16; ++i) S[kb][i] = 0.f;
            for (int t = 0; t < 75; ++t) {
                if (t >= 1 && t <= 72) consume(C, S, t - 1, (t - 1) & 1);
                HG_BAR();
            }
        }
    }
}
}
#ifndef GEMM_ALIGN
#define GEMM_ALIGN true
#endif
#ifndef GEMM_SP2
#define GEMM_SP2 true
#endif
struct Args { const float* in[16]; float* out; unsigned char* ws; int ph_lo, ph_hi, li, pad; };
__global__ void __launch_bounds__(NWAVES * 64, 2) dit_fwd(Args args) {
    extern __shared__ __attribute__((aligned(16))) unsigned char lds[];
    Frame F;
    F.lds = (LAS unsigned char*)lds;
    F.MISC = (volatile LAS unsigned*)(F.lds + MISC_OFF);
    F.tid = threadIdx.x; F.lane = F.tid & 63; F.wave = __builtin_amdgcn_readfirstlane(F.tid >> 6);
    F.G = gridDim.x; { const int bx = blockIdx.x; F.vcu = (F.G % 8 == 0) ? (bx % 8) * (F.G / 8) + bx / 8 : bx; }
    unsigned char* ws = args.ws; F.ws = ws;
    F.ctl = (gu32*)(ws + WS_CTL);
    F.x = args.in[0]; F.c = args.in[1]; F.ctx = args.in[2]; F.c_ctx = args.in[3]; F.norm_w = args.in[4]; F.w_ada = args.in[5]; F.b_ada = args.in[6]; F.w_in = args.in[7];
    F.q_norm_w = args.in[8]; F.k_norm_w = args.in[9]; F.lb_logits = args.in[10]; F.hg_norm_w = args.in[11]; F.w_proj_hg = args.in[12]; F.w_proj_att = args.in[13]; F.w_out = args.in[14]; F.final_norm_w = args.in[15];
    F.out = args.out;
    for (int u = F.tid; u < (LDS_BYTES - LDSCTL_OFF) / 4; u += NWAVES * 64) ((LAS unsigned*)(F.lds + LDSCTL_OFF))[u] = 0u;
    __syncthreads();
    XcdBarrier bar; bar.bar = (unsigned*)(F.ctl + CW_BAR); bar.x = 0; bar.st = nullptr;
    if (N_LAUNCHES == 1) bar = xcd_barrier_post((unsigned*)(F.ctl + CW_BAR), F.MISC + 8);
#define GRID_BAR(seam) do { if (N_LAUNCHES == 1) { xcd_barrier(bar); } } while (0)
    const int lo = args.ph_lo, hi = args.ph_hi;
#ifndef PH_MASK
#define PH_MASK 0xFFFF
#endif
#define IN(k) (((PH_MASK >> (k)) & 1) && lo <= (k) && (k) < hi)
#define BOTH(k) (IN(k) && IN((k) + 1))

#ifndef DUP_PHASE
#define DUP_PHASE -1
#endif
#define PHASE_(k, seam, ...) if (IN(k)) { _Pragma("unroll") for (int rep_ = 0; rep_ < ((DUP_PHASE == (k)) ? 2 : 1); ++rep_) { __VA_ARGS__; if (((seam) && BOTH(k)) || rep_ + 1 < ((DUP_PHASE == (k)) ? 2 : 1)) GRID_BAR(k); } }
#define PHASE(k, ...) PHASE_(k, true, __VA_ARGS__)
#define PHASE_NOSEAM(k, ...) PHASE_(k, N_LAUNCHES != 1, __VA_ARGS__)
    PHASE(0, p0_prologue(F))
    PHASE(1, { p1_modulate(F); p0c_convert(F); })
    PHASE(2, {
        pg8::Gemm g{(const pg8::bf16_t*)(ws + WS_H), (const pg8::bf16_t*)(ws + WS_WIN), MH, NIN, DM}; pg8::InOrder S; S.init(F.G, (int)blockIdx.x);
        pg8::EpiIn E{ws, (const float*)(ws + WS_TAB + TAB_LB)};
        pg8::gemm_phase<pg8::EpiIn, pg8::InOrder, GEMM_ALIGN, GEMM_SP2, true>(F.lds + RING_OFF, g, S, E);
        if (F.G == 256 && ((int)blockIdx.x >> 3) >= 28) p2_tail_convert(F, (((int)blockIdx.x >> 3) - 28) * 8 + ((int)blockIdx.x & 7)); })
    PHASE_NOSEAM(3, hg::phase(F))
    PHASE(4, p3_qk_norm_rope(F))
    PHASE_NOSEAM(5, p5_attention(F))
    PHASE(6, p6_hgrn_out(F))
    PHASE_NOSEAM(7, {
        pg8::Gemm g{(const pg8::bf16_t*)(ws + WS_YHG), (const pg8::bf16_t*)(ws + WS_WPH), MX, DM, DM}; pg8::StaticOrder S; S.init(MX, DM, F.G, (int)blockIdx.x);
        pg8::EpiProjA E{(const pg8::bf16_t*)(ws + WS_RHG), (float*)(ws + WS_TMP)};
        pg8::gemm_phase<pg8::EpiProjA, pg8::StaticOrder, true, true, true>(F.lds + RING_OFF, g, S, E); })
    PHASE(8, {
        pg8::Gemm g{(const pg8::bf16_t*)(ws + WS_YATT), (const pg8::bf16_t*)(ws + WS_WPA), MX, DM, DM}; pg8::StaticOrder S; S.init(MX, DM, F.G, (int)blockIdx.x);
        pg8::EpiProjB E{(const pg8::bf16_t*)(ws + WS_RATT), (const float*)(ws + WS_TMP), (pg8::bf16_t*)(ws + WS_MRG)};
        pg8::gemm_phase<pg8::EpiProjB, pg8::StaticOrder, true, true, true>(F.lds + RING_OFF, g, S, E); })
    PHASE(9, {
        if (F.G == 256) {
            pg8::Gemm g{(const pg8::bf16_t*)(ws + WS_MRG), (const pg8::bf16_t*)(ws + WS_WO), MX, DM, DM};
            pg8::EpiOutNorm E{F.x, (const float*)(ws + WS_TAB + TAB_GATE), F.final_norm_w, F.out, (unsigned*)(ws + WS_XB), (unsigned*)(F.ctl + CW_PANEL), (unsigned*)F.ctl};
            { pg8::RoundOrder S; S.init(F.vcu, 0); pg8::gemm_phase<pg8::EpiOutNorm, pg8::RoundOrder, false, true, true>(F.lds + RING_OFF, g, S, E); }
            __syncthreads();
            { pg8::RoundOrder S; S.init(F.vcu, 1); pg8::gemm_phase<pg8::EpiOutNorm, pg8::RoundOrder, false, true, true>(F.lds + RING_OFF, g, S, E); }
        } else {
            pg8::Gemm g{(const pg8::bf16_t*)(ws + WS_MRG), (const pg8::bf16_t*)(ws + WS_WO), MX, DM, DM}; pg8::StaticOrder S; S.init(MX, DM, F.G, (int)blockIdx.x);
            pg8::EpiOut E{F.x, (const float*)(ws + WS_TAB + TAB_GATE), F.out};
            pg8::gemm_phase<pg8::EpiOut, pg8::StaticOrder, true, true, true>(F.lds + RING_OFF, g, S, E);
            GRID_BAR(9); p10_final_norm(F);
        } })

#undef PHASE
#undef PHASE_NOSEAM
#undef PHASE_
#undef IN
#undef BOTH
}

extern "C" void kernel_launch(void* const* d_in, const int* in_sizes, int n_in, void* d_out, int out_size, void* d_ws, size_t ws_size, hipStream_t stream) {
    static int grid = 0;
    if (grid == 0) {
        if (n_in != 16 || in_sizes[0] != MX * DM || out_size != MX * DM || ws_size < WS_END) { fprintf(stderr, "kernel_launch: shape mismatch: n_in %d in0 %d out %d ws %zu (need %zu); nothing launched\n", n_in, n_in > 0 ? in_sizes[0] : -1, out_size, ws_size, (size_t)WS_END); grid = -1; return; }
        int dev = 0, cus = 0, per_cu = 0;
        if (hipGetDevice(&dev) != hipSuccess || hipDeviceGetAttribute(&cus, hipDeviceAttributeMultiprocessorCount, dev) != hipSuccess) { fprintf(stderr, "kernel_launch: device query failed\n"); grid = -1; return; }
        if (hipFuncSetAttribute((const void*)dit_fwd, hipFuncAttributeMaxDynamicSharedMemorySize, LDS_BYTES) != hipSuccess) { fprintf(stderr, "kernel_launch: hipFuncSetAttribute failed\n"); grid = -1; return; }
        if (hipOccupancyMaxActiveBlocksPerMultiprocessor(&per_cu, (const void*)dit_fwd, NWAVES * 64, LDS_BYTES) != hipSuccess || per_cu < 1)
            fprintf(stderr, "kernel_launch: note: occupancy query reports %d workgroups per CU\n", per_cu);
        (void)hipGetLastError();
        grid = cus;
    }
    if (grid < 0) return;
    if (hipMemsetAsync((char*)d_ws + WS_CTL, 0, CTL_ZERO_BYTES, stream) != hipSuccess) { fprintf(stderr, "kernel_launch: hipMemsetAsync failed\n"); return; }
    Args a{};
    for (int i = 0; i < 16; ++i) a.in[i] = (const float*)d_in[i];
    a.out = (float*)d_out; a.ws = (unsigned char*)d_ws;
    for (int li = 0; li < N_LAUNCHES; ++li) {
        a.ph_lo = (N_LAUNCHES == 1) ? 0 : li; a.ph_hi = (N_LAUNCHES == 1) ? N_PHASES : li + 1; a.li = li; a.pad = 0;
        hipLaunchKernelGGL(dit_fwd, dim3(grid), dim3(NWAVES * 64), LDS_BYTES, stream, a);
        const hipError_t le = hipPeekAtLastError();
        if (le != hipSuccess) { fprintf(stderr, "kernel_launch: launch %d failed: %s\n", li, hipGetErrorName(le)); break; }
    }
}
```

```cpp
#include <hip/hip_runtime.h>
#include <hip/hip_bf16.h>
#include <cstdio>
#include <cstdint>
#include <cmath>
constexpr int BATCH = 4, T = 2048, DM = 4096, LCTX = 256, NH = 32, NKV = 8, HD = 128, SKV = LCTX + T;
constexpr int MX = BATCH * T, MC = BATCH * LCTX, MH = MX + MC;
constexpr int NIN = 38912, NCTX = 14336, NADA = 3 * DM;
constexpr float EPS = 1e-6f;
constexpr size_t MiB = 1u << 20;
constexpr size_t WS_CTL = 0, CTL_ZERO_BYTES = 1 * MiB;
constexpr size_t WS_MODP = 1 * MiB;
constexpr size_t WS_TAB = 2 * MiB;
constexpr size_t TAB_SIN = 96 * 32 * 4, TAB_LB = 2 * 96 * 32 * 4, TAB_GATE = TAB_LB + 2 * 4096 * 4;
constexpr size_t WS_WIN = 4 * MiB;
constexpr size_t WS_WPH = 308 * MiB, WS_WPA = 340 * MiB, WS_WO = 372 * MiB;
constexpr size_t WS_H = 404 * MiB;
constexpr size_t WS_KALL = 476 * MiB, WS_VALL = 494 * MiB;
constexpr size_t WS_VHG = 512 * MiB;
constexpr size_t WS_FF = 584 * MiB, WS_FB = 728 * MiB;
constexpr size_t WS_QATT = 872 * MiB, WS_GATT = 936 * MiB, WS_QHG = 1000 * MiB, WS_GHG = 1064 * MiB, WS_RHG = 1128 * MiB, WS_RATT = 1192 * MiB;
constexpr size_t WS_OF = 1256 * MiB, WS_OB = 1384 * MiB;
constexpr size_t WS_YHG = 1512 * MiB, WS_YATT = 1576 * MiB;
constexpr size_t WS_TMP = 1640 * MiB;
constexpr size_t WS_MRG = 1768 * MiB;
constexpr size_t WS_END = 1832 * MiB;
static_assert(WS_WIN + (size_t)NIN * DM * 2 <= WS_WPH && WS_H + (size_t)MH * DM * 2 <= WS_KALL && WS_KALL + (size_t)BATCH * SKV * 1024 * 2 <= WS_VALL && WS_VALL + (size_t)BATCH * SKV * 1024 * 2 <= WS_VHG, "d_ws map");
static_assert(WS_FF + (size_t)MH * DM * 4 <= WS_FB && WS_FB + (size_t)MH * DM * 4 <= WS_QATT && WS_OF + (size_t)MX * DM * 4 <= WS_OB && WS_TMP + (size_t)MX * DM * 4 <= WS_MRG, "d_ws map");
constexpr size_t WS_XB = 3 * MiB;
constexpr int CW_BAR = 4096, CW_PANEL = 16384;
__host__ __device__ __forceinline__ size_t tm_off(int row, int col) { return ((size_t)(row >> 8) * (DM / 64) + (col >> 6)) * (256 * 64) + (row & 255) * 64 + (col & 63); }
namespace pg8 {
#define PG8_LAS __attribute__((address_space(3)))
typedef unsigned short bf16_t;
typedef short bf16x8 __attribute__((ext_vector_type(8)));
typedef float f32x4 __attribute__((ext_vector_type(4)));
typedef unsigned u32x4 __attribute__((ext_vector_type(4)));
constexpr int BM = 256, BK = 64, HALF = 128, HTB = HALF * BK * 2  , STAGE_BYTES = 8 * HTB, NXCD = 8, WGM = 4;

__host__ __device__ __forceinline__ int lds_byte(int r, int c) { const int st = (r >> 4) * 2 + (c >> 5), rr = r & 15, cc = c & 31, ob = rr * 64 + cc * 2; return st * 1024 + (ob ^ (((ob >> 9) & 1) << 5)); }
__host__ __device__ __forceinline__ void stage_rc(int b, int& R, int& C) { const int st = b / 1024, sb = b % 1024, swz = sb ^ (((sb >> 9) & 1) << 5); R = (st >> 1) * 16 + swz / 64; C = (st & 1) * 32 + (swz % 64) / 2; }
__host__ __device__ __forceinline__ int perm32(int rho) { const int n = rho >> 4, i = rho & 15; return 8 * (i >> 2) + 4 * n + (i & 3); }

struct Unit { int pm, pn; };
struct Gemm { const bf16_t* A; const bf16_t* Bt; int M, N, K; };

struct StaticOrder {
    int nM, nN, nwg, G, c;
    __host__ __device__ void init(int M, int N, int G_, int c_) { nM = M / BM; nN = N / BM; nwg = nM * nN; G = G_; c = c_; }
    __host__ __device__ bool next(int i, Unit& u) const {
        const long L = (long)i * G + c; if (L >= nwg) return false;
        int wgid = (int)L; { const int q = nwg / NXCD, r = nwg % NXCD, xcd = wgid % NXCD, off = wgid / NXCD; wgid = (xcd < r ? xcd * (q + 1) : r * (q + 1) + (xcd - r) * q) + off; }
        const int nig = WGM * nN, gid = wgid / nig, fm = gid * WGM, gsz = (nM - fm) < WGM ? (nM - fm) : WGM;
        u.pm = fm + ((wgid % nig) % gsz); u.pn = (wgid % nig) / gsz; return true;
    }
    __device__ __forceinline__ void a_ready(const Unit&) const {}
    __device__ __forceinline__ void done(const Unit&) const {}
};

__device__ __forceinline__ unsigned cvt_pk_bf16(float lo, float hi) { unsigned r; asm volatile("v_cvt_pk_bf16_f32 %0, %1, %2" : "=v"(r) : "v"(lo), "v"(hi)); return r; }
typedef float f32x2 __attribute__((ext_vector_type(2)));
typedef _Float16 f16x8 __attribute__((ext_vector_type(8)));
__device__ __forceinline__ float sigm(float v) { return __builtin_amdgcn_rcpf(1.0f + __builtin_amdgcn_exp2f(-1.4426950408889634f * v)); }
__device__ __forceinline__ float bf_lo(unsigned w) { return __uint_as_float(w << 16); }
__device__ __forceinline__ float bf_hi(unsigned w) { return __uint_as_float(w & 0xffff0000u); }
struct InOrder {
    StaticOrder so; int G, c;
    __host__ __device__ void init(int G_, int c_) { so.init(MX, NIN, G_, c_); G = G_; c = c_; }
    __host__ __device__ bool next(int i, Unit& u) const {
        if (G == 256 && so.nwg == 19 * 256) {
            if (i < 19) { const int x = c & 7, q = c >> 3; u.pm = 4 * x + (q & 3); u.pn = 8 * i + (q >> 2); return true; }
        } else
        if (so.next(i, u)) return true;
        const long L = (long)i * G + c - so.nwg; if (L >= 4 * 56) return false;
        if (G == 256 && so.nwg % 256 == 0) {
            const int x = c & 7, j = c >> 3; if (j >= 28) return false;
            u.pm = 32 + (j & 3); u.pn = 7 * x + (j >> 2); return true; }
        u.pm = 32 + (int)(L & 3); u.pn = (int)(L >> 2); return true;
    }
    __device__ __forceinline__ void a_ready(const Unit&) const {}
    __device__ __forceinline__ void done(const Unit&) const {}
};
struct EpiIn {
    static constexpr bool PERM = true, AFTER_DRAIN = false;
    unsigned char* ws; const float* lb;
    __device__ __forceinline__ void operator()(const f32x4 (&acc)[2][2][4][2], const Unit& u, int wr, int wc, int fr, int fq) const {
        const int pn = u.pn, pm = u.pm;
        int mode, ld, cpn, hrows = 0, hpb = NH; size_t off;
        if (pn < 4)        { mode = 0; off = WS_KALL; ld = 1024; cpn = pn; hrows = SKV; hpb = NKV; }
        else if (pn < 8)   { mode = 0; off = WS_VALL; ld = 1024; cpn = pn - 4; hrows = SKV; hpb = NKV; }
        else if (pn < 24)  { mode = 0; off = WS_VHG;  ld = DM; cpn = pn - 8; hrows = SKV; }
        else if (pn < 40)  { mode = 3; off = WS_FF;   ld = DM; cpn = pn - 24; hrows = SKV; }
        else if (pn < 56)  { mode = 4; off = WS_FB;   ld = DM; cpn = pn - 40; hrows = SKV; }
        else if (pn < 72)  { mode = 0; off = WS_QATT; ld = DM; cpn = pn - 56; hrows = T; }
        else if (pn < 88)  { mode = 0; off = WS_GATT; ld = DM; cpn = pn - 72; hrows = T; }
        else if (pn < 104) { mode = 1; off = WS_QHG;  ld = DM; cpn = pn - 88; hrows = T; }
        else if (pn < 120) { mode = 0; off = WS_GHG;  ld = DM; cpn = pn - 104; hrows = T; }
        else if (pn < 136) { mode = 0; off = WS_RHG;  ld = DM; cpn = pn - 120; }
        else               { mode = 0; off = WS_RATT; ld = DM; cpn = pn - 136; }
        int row0 = pm * 256;
        size_t hm_step = 0;
        if (hrows) { const int bb = pm < 32 ? pm >> 3 : pm - 32, pos0 = pm < 32 ? (hrows - T) + (pm & 7) * 256 : 0;
            off += (((size_t)(bb * hpb + cpn * 2) * hrows + pos0) * HD) * 2; row0 = 0; ld = HD; hm_step = (size_t)hrows * HD; }
        const int rloc = wr * 64 + fr, cloc = cpn * 256 + wc * 32 + 8 * fq, dcol = hrows ? wc * 32 + 8 * fq : cloc; const size_t bjs = hrows ? hm_step : (size_t)HALF;
        if (mode >= 3) {
            _Float16* base = (_Float16*)(ws + off);
#pragma unroll
            for (int ai = 0; ai < 2; ++ai)
#pragma unroll
                for (int m = 0; m < 4; ++m) { _Float16* rowp = base + (size_t)(row0 + rloc + ai * HALF + m * 16) * ld + dcol;
#pragma unroll
                    for (int bj = 0; bj < 2; ++bj) { const f32x4 v0 = acc[ai][bj][m][0], v1 = acc[ai][bj][m][1]; f16x8 o;
#pragma unroll
                        for (int j = 0; j < 4; ++j) { o[j] = (_Float16)v0[j]; o[4 + j] = (_Float16)v1[j]; }
                        *(f16x8*)(rowp + bj * bjs) = o; } }
        } else {
            bf16_t* base = (bf16_t*)(ws + off);
#pragma unroll
            for (int ai = 0; ai < 2; ++ai)
#pragma unroll
                for (int m = 0; m < 4; ++m) { bf16_t* rowp = base + (size_t)(row0 + rloc + ai * HALF + m * 16) * ld + dcol;
#pragma unroll
                    for (int bj = 0; bj < 2; ++bj) { f32x4 v0 = acc[ai][bj][m][0], v1 = acc[ai][bj][m][1];
                        if (mode != 0) {
#pragma unroll
                            for (int j = 0; j < 4; ++j) { v0[j] *= sigm(v0[j]); v1[j] *= sigm(v1[j]); } }
                        u32x4 w; w.x = cvt_pk_bf16(v0[0], v0[1]); w.y = cvt_pk_bf16(v0[2], v0[3]); w.z = cvt_pk_bf16(v1[0], v1[1]); w.w = cvt_pk_bf16(v1[2], v1[3]);
                        *(u32x4*)(rowp + bj * bjs) = w; } }
        }
    }
};
struct EpiProjA {
    static constexpr bool PERM = true, AFTER_DRAIN = false;
    const bf16_t* R; float* tmp;
    __device__ __forceinline__ void operator()(const f32x4 (&acc)[2][2][4][2], const Unit& u, int wr, int wc, int fr, int fq) const {
        const int row0 = u.pm * BM + wr * 64 + fr, col0 = u.pn * BM + wc * 32 + 8 * fq;
#pragma unroll
        for (int ai = 0; ai < 2; ++ai)
#pragma unroll
            for (int m = 0; m < 4; ++m) { const size_t ro = (size_t)(row0 + ai * HALF + m * 16) * DM + col0;
#pragma unroll
                for (int bj = 0; bj < 2; ++bj) { const u32x4 r = *(const u32x4*)(R + ro + bj * HALF); const f32x4 v0 = acc[ai][bj][m][0], v1 = acc[ai][bj][m][1];
                    const f32x4 o0 = {v0[0] * sigm(bf_lo(r.x)), v0[1] * sigm(bf_hi(r.x)), v0[2] * sigm(bf_lo(r.y)), v0[3] * sigm(bf_hi(r.y))};
                    const f32x4 o1 = {v1[0] * sigm(bf_lo(r.z)), v1[1] * sigm(bf_hi(r.z)), v1[2] * sigm(bf_lo(r.w)), v1[3] * sigm(bf_hi(r.w))};
                    *(f32x4*)(tmp + ro + bj * HALF) = o0; *(f32x4*)(tmp + ro + bj * HALF + 4) = o1; } }
    }
};
struct EpiProjB {
    static constexpr bool PERM = true, AFTER_DRAIN = false;
    const bf16_t* R; const float* tmp; bf16_t* O;
    __device__ __forceinline__ void operator()(const f32x4 (&acc)[2][2][4][2], const Unit& u, int wr, int wc, int fr, int fq) const {
        const int row0 = u.pm * BM + wr * 64 + fr, col0 = u.pn * BM + wc * 32 + 8 * fq;
#pragma unroll
        for (int ai = 0; ai < 2; ++ai)
#pragma unroll
            for (int m = 0; m < 4; ++m) { const size_t ro = (size_t)(row0 + ai * HALF + m * 16) * DM + col0;
#pragma unroll
                for (int bj = 0; bj < 2; ++bj) { const u32x4 r = *(const u32x4*)(R + ro + bj * HALF); const f32x4 t0 = *(const f32x4*)(tmp + ro + bj * HALF), t1 = *(const f32x4*)(tmp + ro + bj * HALF + 4);
                    const f32x4 v0 = acc[ai][bj][m][0], v1 = acc[ai][bj][m][1];
                    const f32x4 o0 = {t0[0] + v0[0] * sigm(bf_lo(r.x)), t0[1] + v0[1] * sigm(bf_hi(r.x)), t0[2] + v0[2] * sigm(bf_lo(r.y)), t0[3] + v0[3] * sigm(bf_hi(r.y))};
                    const f32x4 o1 = {t1[0] + v1[0] * sigm(bf_lo(r.z)), t1[1] + v1[1] * sigm(bf_hi(r.z)), t1[2] + v1[2] * sigm(bf_lo(r.w)), t1[3] + v1[3] * sigm(bf_hi(r.w))};
                    u32x4 w; w.x = cvt_pk_bf16(o0[0], o0[1]); w.y = cvt_pk_bf16(o0[2], o0[3]); w.z = cvt_pk_bf16(o1[0], o1[1]); w.w = cvt_pk_bf16(o1[2], o1[3]);
                    *(u32x4*)(O + tm_off(row0 + ai * HALF + m * 16, col0 + bj * HALF)) = w; } }
    }
};
struct EpiOut {
    static constexpr bool PERM = false, AFTER_DRAIN = false;
    const float* x; const float* gate; float* out;
    __device__ __forceinline__ void operator()(const f32x4 (&acc)[2][2][4][2], const Unit& u, int wr, int wc, int fr, int fq) const {
        const int row0 = u.pm * BM + wr * 64 + fr, col0 = u.pn * BM + wc * 32 + 4 * fq;
        const float* gp = gate + (u.pm >> 3) * DM + col0;
        f32x4 gv[2][2];
#pragma unroll
        for (int bj = 0; bj < 2; ++bj)
#pragma unroll
            for (int n = 0; n < 2; ++n) gv[bj][n] = *(const f32x4*)(gp + bj * HALF + n * 16);
#pragma unroll
        for (int ai = 0; ai < 2; ++ai)
#pragma unroll
            for (int m = 0; m < 4; ++m) { const size_t ro = (size_t)(row0 + ai * HALF + m * 16) * DM + col0;
#pragma unroll
                for (int bj = 0; bj < 2; ++bj)
#pragma unroll
                    for (int n = 0; n < 2; ++n) { const f32x4 xv = *(const f32x4*)(x + ro + bj * HALF + n * 16); *(f32x4*)(out + ro + bj * HALF + n * 16) = xv + gv[bj][n] * acc[ai][bj][m][n]; } }
    }
};
struct RoundOrder {
    int pm, pn;
    __host__ __device__ void init(int vcu, int rnd) { const int x = vcu >> 5, q = vcu & 31; pm = 16 * rnd + 4 * (x >> 1) + (q & 3); pn = 8 * (x & 1) + (q >> 2); }
    __host__ __device__ bool next(int i, Unit& u) const { if (i > 0) return false; u.pm = pm; u.pn = pn; return true; }
    __device__ __forceinline__ void a_ready(const Unit&) const {}
    __device__ __forceinline__ void done(const Unit&) const {}
};
struct EpiOutNorm {
    static constexpr bool PERM = false, AFTER_DRAIN = true, HAS_MID = false;
    const float* x; const float* gate; const float* fw; float* out; unsigned* xbuf; unsigned* cnt; unsigned* tmo;
    __device__ __forceinline__ void early(f32x4 (&)[2][2][4][2], const Unit&, int, int, int, int, PG8_LAS unsigned char*) const {}
    __device__ __forceinline__ void fused(f32x4 (&acc)[2][2][4][2], const Unit& u, int wr, int wc, int fr, int fq, PG8_LAS unsigned char* lds, int wid, int lane) const {
        PG8_LAS float* P = (PG8_LAS float*)lds; PG8_LAS float* R = P + 1024; PG8_LAS unsigned* flag = (PG8_LAS unsigned*)(R + 256);
        const int row0 = u.pm * BM + wr * 64 + fr, col0 = u.pn * BM + wc * 32 + 4 * fq;
        {
            const float* gp = gate + (u.pm >> 3) * DM + col0;
            f32x4 gv[2][2];
#pragma unroll
            for (int bj = 0; bj < 2; ++bj)
#pragma unroll
                for (int n = 0; n < 2; ++n) gv[bj][n] = *(const f32x4*)(gp + bj * HALF + n * 16);
            f32x4 xv[2][2][2];
#define EON_LOAD(slot, g) do { const size_t ro_ = (size_t)(row0 + ((g) >> 2) * HALF + ((g) & 3) * 16) * DM + col0; _Pragma("unroll") for (int bj = 0; bj < 2; ++bj) _Pragma("unroll") for (int n = 0; n < 2; ++n) xv[slot][bj][n] = *(const f32x4*)(x + ro_ + bj * HALF + n * 16); } while (0)
            EON_LOAD(0, 0);
#pragma unroll
            for (int g = 0; g < 8; ++g) { const int ai = g >> 2, m = g & 3, sl = g & 1;
                if (g + 1 < 8) { if (sl) EON_LOAD(0, g + 1); else EON_LOAD(1, g + 1); }
#pragma unroll
                for (int bj = 0; bj < 2; ++bj)
#pragma unroll
                    for (int n = 0; n < 2; ++n) acc[ai][bj][m][n] = xv[sl][bj][n] + gv[bj][n] * acc[ai][bj][m][n];
                asm volatile("" : "+v"(acc[ai][0][m][0]), "+v"(acc[ai][0][m][1]), "+v"(acc[ai][1][m][0]), "+v"(acc[ai][1][m][1]) :: "memory"); }
#undef EON_LOAD
        }
#pragma unroll
        for (int ai = 0; ai < 2; ++ai)
#pragma unroll
            for (int m = 0; m < 4; ++m) { float s = 0.f;
#pragma unroll
                for (int bj = 0; bj < 2; ++bj)
#pragma unroll
                    for (int n = 0; n < 2; ++n) { const f32x4 v = acc[ai][bj][m][n]; s += (v[0] * v[0] + v[1] * v[1]) + (v[2] * v[2] + v[3] * v[3]); }
                s += __shfl_xor(s, 16); s += __shfl_xor(s, 32);
                if (fq == 0) P[(ai * HALF + wr * 64 + m * 16 + fr) * 4 + wc] = s; }
        asm volatile("s_waitcnt lgkmcnt(0)" ::: "memory"); __builtin_amdgcn_s_barrier(); asm volatile("" ::: "memory");
        const int row = wid * 32 + (lane & 31);
        if (lane < 32) { const f32x4 a = *(const PG8_LAS f32x4*)(P + row * 4);
            __hip_atomic_store(xbuf + (size_t)(u.pm * BM + row) * 16 + u.pn, __float_as_uint((a[0] + a[1]) + (a[2] + a[3])), __ATOMIC_RELAXED, __HIP_MEMORY_SCOPE_AGENT); }
        asm volatile("s_waitcnt vmcnt(0)" ::: "memory");
        if (lane == 0) __hip_atomic_fetch_add(cnt + 64 * u.pm, 1u, __ATOMIC_RELAXED, __HIP_MEMORY_SCOPE_AGENT);
        if (wid == 0) {
            bool dead = false;
            for (unsigned spins = 0;; ++spins) {
                if ((unsigned)__builtin_amdgcn_readfirstlane(__hip_atomic_load(cnt + 64 * u.pm, __ATOMIC_RELAXED, __HIP_MEMORY_SCOPE_AGENT)) >= 128u) break;
                if (spins > (1u << 18)) { if (lane == 0) __hip_atomic_store(tmo, 1u, __ATOMIC_RELAXED, __HIP_MEMORY_SCOPE_AGENT); dead = true; break; }
                __builtin_amdgcn_s_sleep(2);
            }
            __builtin_amdgcn_fence(__ATOMIC_ACQUIRE, "agent");
            if (lane == 0) flag[0] = dead ? 1u : 0u;
        }
        asm volatile("s_waitcnt vmcnt(0) lgkmcnt(0)" ::: "memory"); __builtin_amdgcn_s_barrier(); asm volatile("" ::: "memory");
        const bool bad = flag[0] != 0u;
        if (lane < 32) { const unsigned* slot = xbuf + (size_t)(u.pm * BM + row) * 16; float ss = 0.f;
#pragma unroll
            for (int t = 0; t < 16; ++t) ss += __uint_as_float(__hip_atomic_load(slot + t, __ATOMIC_RELAXED, __HIP_MEMORY_SCOPE_AGENT));
            R[row] = bad ? __builtin_nanf("") : 1.0f / sqrtf(ss * (1.0f / DM) + EPS); }
        asm volatile("s_waitcnt lgkmcnt(0)" ::: "memory"); __builtin_amdgcn_s_barrier(); asm volatile("" ::: "memory");
        f32x4 wv[2][2];
#pragma unroll
        for (int bj = 0; bj < 2; ++bj)
#pragma unroll
            for (int n = 0; n < 2; ++n) wv[bj][n] = *(const f32x4*)(fw + col0 + bj * HALF + n * 16);
#pragma unroll
        for (int ai = 0; ai < 2; ++ai)
#pragma unroll
            for (int m = 0; m < 4; ++m) { const int rl = ai * HALF + wr * 64 + m * 16 + fr; const float rs = R[rl]; float* op = out + (size_t)(u.pm * BM + rl) * DM + col0;
#pragma unroll
                for (int bj = 0; bj < 2; ++bj)
#pragma unroll
                    for (int n = 0; n < 2; ++n) *(f32x4*)(op + bj * HALF + n * 16) = acc[ai][bj][m][n] * rs * wv[bj][n];
                asm volatile("" ::: "memory"); }
    }
};
template <class Epi, class Sched, bool ALIGN_EPI = false, bool SP2 = false, bool ATILED = false>
__device__ __forceinline__ void gemm_phase(PG8_LAS unsigned char* lds, const Gemm g, const Sched& S, const Epi& E) {
    const int tid = threadIdx.x, wid = __builtin_amdgcn_readfirstlane(tid >> 6), lane = tid & 63, wr = wid >> 2, wc = wid & 3, fr = lane & 15, fq = lane >> 4;
    const int K = g.K, nt = K / BK;
    unsigned voffA[2], voffB[2];
#pragma unroll
    for (int i = 0; i < 2; ++i) { int R, C; stage_rc(tid * 16 + i * 8192, R, C); const int Rb = Epi::PERM ? ((R & ~31) + perm32(R & 31)) : R;
        voffA[i] = (unsigned)(R * (ATILED ? BK : K) + C) * 2u; voffB[i] = (unsigned)(Rb * BK + C) * 2u; }
    const size_t kstep = (size_t)(BK * 2);
    const size_t hstep = (size_t)HALF * K * 2;
    const size_t tstep = 2 * hstep;
    const size_t kstepA = ATILED ? (size_t)BM * BK * 2 : kstep, hstepA = ATILED ? (size_t)HALF * BK * 2 : hstep;
    const size_t kstepB = (size_t)BM * BK * 2, hstepB = (size_t)HALF * BK * 2;
    const unsigned ldsw = (unsigned)wid * 1024u;
    const int aoff = lds_byte(wr * 64 + fr, fq * 8), boff = lds_byte(wc * 32 + fr, fq * 8);
#define PG8_SA(b, h) (((b) * 2 + (h)) * HTB)
#define PG8_SB(b, h) ((4 + (b) * 2 + (h)) * HTB)
#define PG8_STAGE(bufoff, gbase, voff) do { _Pragma("unroll") for (int _i = 0; _i < 2; ++_i) \
        __builtin_amdgcn_global_load_lds((const unsigned*)((const char*)(gbase) + (voff)[_i]), (PG8_LAS unsigned*)(lds + (bufoff) + ldsw + _i * 8192), 16, 0, 0); } while (0)
#define PG8_LDA(dst, b, h) do { _Pragma("unroll") for (int m = 0; m < 4; ++m) _Pragma("unroll") for (int k = 0; k < 2; ++k) dst[m][k] = *(const PG8_LAS bf16x8*)(lds + PG8_SA(b, h) + aoff + m * 2048 + k * 1024); } while (0)
#define PG8_LDB(dst, b, h) do { _Pragma("unroll") for (int n = 0; n < 2; ++n) _Pragma("unroll") for (int k = 0; k < 2; ++k) dst[n][k] = *(const PG8_LAS bf16x8*)(lds + PG8_SB(b, h) + boff + n * 2048 + k * 1024); } while (0)
#define PG8_MMA(ai, bj, At, Bt) do { __builtin_amdgcn_s_setprio(1); _Pragma("unroll") for (int m = 0; m < 4; ++m) _Pragma("unroll") for (int n = 0; n < 2; ++n) _Pragma("unroll") for (int k = 0; k < 2; ++k) \
        acc[ai][bj][m][n] = __builtin_amdgcn_mfma_f32_16x16x32_bf16(Bt[n][k], At[m][k], acc[ai][bj][m][n], 0, 0, 0); __builtin_amdgcn_s_setprio(0); } while (0)
#define PG8_WAIT_V(n) asm volatile("s_waitcnt vmcnt(" #n ")" ::: "memory")
#define PG8_WAIT_L(n) asm volatile("s_waitcnt lgkmcnt(" #n ")" ::: "memory")
#define PG8_BAR __builtin_amdgcn_s_barrier()
#define PG8_SCHED __builtin_amdgcn_sched_barrier(0)
    Unit cur, nxt; int ui = 0;
    if (!S.next(0, cur)) return;
    f32x4 acc[2][2][4][2];
#pragma unroll
    for (int a = 0; a < 2; ++a)
#pragma unroll
        for (int b = 0; b < 2; ++b)
#pragma unroll
            for (int m = 0; m < 4; ++m)
#pragma unroll
                for (int n = 0; n < 2; ++n) acc[a][b][m][n] = (f32x4){0.f, 0.f, 0.f, 0.f};
    bf16x8 At[4][2], B0[2][2], B1[2][2];
    const char* cA = (const char*)g.A + (size_t)cur.pm * tstep; const char* cB = (const char*)g.Bt + (size_t)cur.pn * tstep;
    S.a_ready(cur);
    if constexpr (SP2) {
        PG8_STAGE(PG8_SB(0, 0), cB, voffB); PG8_STAGE(PG8_SB(0, 1), cB + hstepB, voffB); PG8_STAGE(PG8_SA(0, 0), cA, voffA); PG8_STAGE(PG8_SA(0, 1), cA + hstepA, voffA);
        if (wr == 1) PG8_BAR;
        PG8_WAIT_V(2); PG8_BAR;
        PG8_STAGE(PG8_SB(1, 0), cB + kstepB, voffB); PG8_STAGE(PG8_SA(1, 0), cA + kstepA, voffA); PG8_STAGE(PG8_SB(1, 1), cB + hstepB + kstepB, voffB);
        PG8_WAIT_V(6); PG8_BAR;
    } else {
        PG8_STAGE(PG8_SB(0, 0), cB, voffB); PG8_STAGE(PG8_SA(0, 0), cA, voffA); PG8_STAGE(PG8_SB(0, 1), cB + hstepB, voffB); PG8_STAGE(PG8_SA(0, 1), cA + hstepA, voffA);
        if (wr == 1) PG8_BAR;
        PG8_WAIT_V(4); PG8_BAR;
        PG8_STAGE(PG8_SB(1, 0), cB + kstepB, voffB); PG8_STAGE(PG8_SA(1, 0), cA + kstepA, voffA); PG8_STAGE(PG8_SB(1, 1), cB + hstepB + kstepB, voffB);
        PG8_WAIT_V(6); PG8_BAR;
    }
    for (;;) {
        const bool has_next = S.next(ui + 1, nxt);
        const char* nA = has_next ? (const char*)g.A + (size_t)nxt.pm * tstep : cA; const char* nB = has_next ? (const char*)g.Bt + (size_t)nxt.pn * tstep : cB;
        for (int t = 0; t < nt; t += 2) {
            const bool last = (t == nt - 2);
            const char* a1 = cA + (size_t)(t + 1) * kstepA;
            const char* a2 = last ? nA : cA + (size_t)(t + 2) * kstepA; const char* b2 = last ? nB : cB + (size_t)(t + 2) * kstepB;
            const char* a3 = a2 + kstepA; const char* b3 = b2 + kstepB;
            if (last && has_next) S.a_ready(nxt);
            if constexpr (SP2) {
            PG8_LDB(B0, 0, 0); PG8_LDB(B1, 0, 1); PG8_SCHED; PG8_LDA(At, 0, 0); PG8_STAGE(PG8_SA(1, 1), a1 + hstepA, voffA);
            PG8_WAIT_V(8); PG8_WAIT_L(0); PG8_BAR; PG8_MMA(0, 0, At, B0); PG8_MMA(0, 1, At, B1); PG8_BAR; PG8_SCHED;
            PG8_LDA(At, 0, 1); PG8_STAGE(PG8_SB(0, 0), b2, voffB); PG8_STAGE(PG8_SB(0, 1), b2 + hstepB, voffB); PG8_STAGE(PG8_SA(0, 0), a2, voffA);
            PG8_WAIT_V(8); PG8_WAIT_L(0); PG8_BAR; PG8_MMA(1, 0, At, B0); PG8_MMA(1, 1, At, B1); PG8_BAR; PG8_SCHED;
            PG8_LDB(B0, 1, 0); PG8_LDB(B1, 1, 1); PG8_SCHED; PG8_LDA(At, 1, 0); PG8_STAGE(PG8_SA(0, 1), a2 + hstepA, voffA);
            PG8_WAIT_V(8); PG8_WAIT_L(0); PG8_BAR; PG8_MMA(0, 0, At, B0); PG8_MMA(0, 1, At, B1); PG8_BAR; PG8_SCHED;
            PG8_LDA(At, 1, 1); PG8_STAGE(PG8_SB(1, 0), b3, voffB); PG8_STAGE(PG8_SB(1, 1), b3 + hstepB, voffB); PG8_STAGE(PG8_SA(1, 0), a3, voffA);
            PG8_WAIT_V(8); PG8_WAIT_L(0); PG8_BAR; PG8_MMA(1, 0, At, B0); PG8_MMA(1, 1, At, B1); PG8_BAR; PG8_SCHED;
            } else {
            PG8_LDB(B0, 0, 0); PG8_SCHED; PG8_LDA(At, 0, 0); PG8_STAGE(PG8_SA(1, 1), a1 + hstepA, voffA);
            PG8_WAIT_L(8); PG8_BAR; PG8_WAIT_L(0); PG8_MMA(0, 0, At, B0); PG8_BAR; PG8_SCHED;
            PG8_LDB(B1, 0, 1); PG8_STAGE(PG8_SB(0, 0), b2, voffB);
            PG8_BAR; PG8_WAIT_L(0); PG8_MMA(0, 1, At, B1); PG8_BAR;
            PG8_LDA(At, 0, 1); PG8_STAGE(PG8_SA(0, 0), a2, voffA);
            PG8_BAR; PG8_WAIT_L(0); PG8_MMA(1, 0, At, B0); PG8_BAR; PG8_SCHED;
            PG8_STAGE(PG8_SB(0, 1), b2 + hstepB, voffB);
            PG8_WAIT_V(6); PG8_BAR; PG8_MMA(1, 1, At, B1); PG8_BAR;
            PG8_LDB(B0, 1, 0); PG8_SCHED; PG8_LDA(At, 1, 0); PG8_STAGE(PG8_SA(0, 1), a2 + hstepA, voffA);
            PG8_WAIT_L(8); PG8_BAR; PG8_WAIT_L(0); PG8_MMA(0, 0, At, B0); PG8_BAR; PG8_SCHED;
            PG8_LDB(B1, 1, 1); PG8_STAGE(PG8_SB(1, 0), b3, voffB);
            PG8_BAR; PG8_WAIT_L(0); PG8_MMA(0, 1, At, B1); PG8_BAR;
            PG8_LDA(At, 1, 1); PG8_STAGE(PG8_SA(1, 0), a3, voffA);
            PG8_BAR; PG8_WAIT_L(0); PG8_MMA(1, 0, At, B0); PG8_BAR; PG8_SCHED;
            PG8_STAGE(PG8_SB(1, 1), b3 + hstepB, voffB);
            PG8_WAIT_V(6); PG8_BAR; PG8_MMA(1, 1, At, B1); PG8_BAR;
            }
        }
        if constexpr (ALIGN_EPI) { if (wr == 0) PG8_BAR; }
        if constexpr (!Epi::AFTER_DRAIN) { E(acc, cur, wr, wc, fr, fq); S.done(cur); }
        else { if (has_next) { E.early(acc, cur, wr, wc, fr, fq, lds); S.done(cur); } }
        if (!has_next) break;
#pragma unroll
        for (int a = 0; a < 2; ++a)
#pragma unroll
            for (int b = 0; b < 2; ++b)
#pragma unroll
                for (int m = 0; m < 4; ++m)
#pragma unroll
                    for (int n = 0; n < 2; ++n) acc[a][b][m][n] = (f32x4){0.f, 0.f, 0.f, 0.f};
        cur = nxt; cA = nA; cB = nB; ++ui;
        if constexpr (ALIGN_EPI) { if (wr == 1) PG8_BAR; }
    }
    PG8_WAIT_V(0);
    if constexpr (!ALIGN_EPI) { if (wr == 0) PG8_BAR; }
    PG8_BAR;
    if constexpr (Epi::AFTER_DRAIN) { E.fused(acc, cur, wr, wc, fr, fq, lds, wid, lane); S.done(cur); }
#undef PG8_SA
#undef PG8_SB
#undef PG8_STAGE
#undef PG8_LDA
#undef PG8_LDB
#undef PG8_MMA
#undef PG8_WAIT_V
#undef PG8_WAIT_L
#undef PG8_BAR
#undef PG8_SCHED
}
}
namespace attn {
using bf16 = __hip_bfloat16;
constexpr int D = 128, NW = 8, QBLK = 32, KVBLK = 64;
constexpr float SCALE = 0.088388347648318440f;
constexpr float THR = 8.f;
#ifndef ATTN_SDEPTH
#define ATTN_SDEPTH 2
#endif
constexpr int SDEPTH = ATTN_SDEPTH;
constexpr int LDQ = D, LDK = D, LDO = D;
constexpr size_t SHM_V = KVBLK * D * 2, SHM_K = KVBLK * D * 2, SHM_ATTN = 2 * SHM_V + 2 * SHM_K + NW * 64 * 4, SHM_TOTAL = SHM_ATTN + NW * QBLK * D * 2;
using bf16x8 = __attribute__((ext_vector_type(8))) short;
using s16x4  = __attribute__((ext_vector_type(4))) short;
using f32x16 = __attribute__((ext_vector_type(16))) float;
using u32x4  = __attribute__((ext_vector_type(4))) unsigned;
#define KSWZ(row, colB) ((row) * 256 + ((colB) ^ (((row) & 7) << 4)))
#define SBAR() __builtin_amdgcn_sched_barrier(0)
__device__ __forceinline__ int crow(int r, int hi) { return (r & 3) + 8 * (r >> 2) + 4 * hi; }
__device__ __forceinline__ unsigned cvtpk(float lo, float hi) { unsigned r; asm volatile("v_cvt_pk_bf16_f32 %0, %1, %2" : "=v"(r) : "v"(lo), "v"(hi)); return r; }
__device__ __forceinline__ bf16x8 ld8(const bf16* p) { return *reinterpret_cast<const bf16x8*>(p); }
__device__ __forceinline__ void partialSM(f32x16& p0, f32x16& p1, float& m_reg, float& mn, float& alpha) {
  constexpr float C = SCALE * 1.4426950408889634f;
  float pmax = p0[0]; for (int r = 1; r < 16; ++r) pmax = fmaxf(pmax, p0[r]); for (int r = 0; r < 16; ++r) pmax = fmaxf(pmax, p1[r]);
  { auto rr = __builtin_amdgcn_permlane32_swap(__float_as_uint(pmax), __float_as_uint(pmax), false, false);
    pmax = fmaxf(__uint_as_float(rr[0]), __uint_as_float(rr[1])); }
  if (__builtin_expect(__all(pmax - m_reg <= THR / SCALE), 1)) { mn = m_reg; alpha = 1.f; }
  else { mn = fmaxf(m_reg, pmax); alpha = __builtin_amdgcn_exp2f((m_reg - mn) * C); m_reg = mn; }
  float mnC = -mn * C;
  for (int r = 0; r < 16; ++r) p0[r] = fmaf(p0[r], C, mnC); for (int r = 0; r < 16; ++r) p1[r] = fmaf(p1[r], C, mnC);
  for (int r = 0; r < 16; ++r) p0[r] = __builtin_amdgcn_exp2f(p0[r]);
}
__device__ __forceinline__ void finishSM(f32x16& p0, f32x16& p1, float alpha, float& l_reg, bf16x8& pa0, bf16x8& pa1, bf16x8& pa2, bf16x8& pa3) {
  for (int r = 0; r < 16; ++r) p1[r] = __builtin_amdgcn_exp2f(p1[r]);
  float ps = 0; for (int r = 0; r < 16; ++r) ps += p0[r]; for (int r = 0; r < 16; ++r) ps += p1[r];
  { auto rr = __builtin_amdgcn_permlane32_swap(__float_as_uint(ps), __float_as_uint(ps), false, false);
    ps = __uint_as_float(rr[0]) + __uint_as_float(rr[1]); }
  l_reg = l_reg * alpha + ps;
#define PK4(P, BASE, OUT) do { unsigned a0 = cvtpk(P[BASE + 0], P[BASE + 1]), a1 = cvtpk(P[BASE + 2], P[BASE + 3]);   \
    unsigned b0 = cvtpk(P[BASE + 4], P[BASE + 5]), b1 = cvtpk(P[BASE + 6], P[BASE + 7]);                              \
    auto r0 = __builtin_amdgcn_permlane32_swap(a0, b0, false, false); auto r1 = __builtin_amdgcn_permlane32_swap(a1, b1, false, false); \
    u32x4 w = {r0[0], r1[0], r0[1], r1[1]}; OUT = *reinterpret_cast<bf16x8*>(&w); } while (0)
  PK4(p0, 0, pa0); PK4(p0, 8, pa1); PK4(p1, 0, pa2); PK4(p1, 8, pa3);
#undef PK4
}
__device__ __forceinline__ void qkt(f32x16& p0, f32x16& p1, const bf16* Ks, const bf16x8* qr, int r32, int hi) {
  p0 = f32x16{}; p1 = f32x16{};
  for (int d0 = 0; d0 < 8; ++d0) { int cb = (d0 * 16 + hi * 8) * 2;
    bf16x8 b0 = *reinterpret_cast<const bf16x8*>((const char*)Ks + KSWZ(r32, cb));
    bf16x8 b1 = *reinterpret_cast<const bf16x8*>((const char*)Ks + KSWZ(32 + r32, cb));
    p0 = __builtin_amdgcn_mfma_f32_32x32x16_bf16(b0, qr[d0], p0, 0, 0, 0);
    p1 = __builtin_amdgcn_mfma_f32_32x32x16_bf16(b1, qr[d0], p1, 0, 0, 0); }
}
__device__ __forceinline__ int v_st(int k, int c) { const int kk = (k & ~0xC) | ((k & 4) << 1) | ((k & 8) >> 1); return ((kk >> 3) * 4 + (c >> 5)) * 512 + ((kk & 7) * 32 + (c & 31)) * 2; }
__device__ __forceinline__ int v_rd_base(int lane) { return ((lane & 3) << 3) | (((lane >> 2) & 3) << 6) | (((lane >> 4) & 1) << 5) | (((lane >> 5) & 1) << 8); }
constexpr int v_rd_off(int d0, int ks, int half) { return d0 * 512 + ks * 4096 + half * 2048; }
template <int OFF> __device__ __forceinline__ s16x4 tr_read(int vb) {
  s16x4 r; asm volatile("ds_read_b64_tr_b16 %0, %1 offset:%2" : "=&v"(r) : "v"(vb), "i"(OFF) : "memory"); return r;
}
template <int D0> __device__ __forceinline__ void pv_one(f32x16& od, int vb, bf16x8 pa0, bf16x8 pa1, bf16x8 pa2, bf16x8 pa3) {
  const s16x4 l0 = tr_read<v_rd_off(D0, 0, 0)>(vb), h0 = tr_read<v_rd_off(D0, 0, 1)>(vb), l1 = tr_read<v_rd_off(D0, 1, 0)>(vb), h1 = tr_read<v_rd_off(D0, 1, 1)>(vb);
  const s16x4 l2 = tr_read<v_rd_off(D0, 2, 0)>(vb), h2 = tr_read<v_rd_off(D0, 2, 1)>(vb), l3 = tr_read<v_rd_off(D0, 3, 0)>(vb), h3 = tr_read<v_rd_off(D0, 3, 1)>(vb);
  asm volatile("s_waitcnt lgkmcnt(0)" ::: "memory"); SBAR();
#define PK(L, H) (bf16x8){L[0], L[1], L[2], L[3], H[0], H[1], H[2], H[3]}
  od = __builtin_amdgcn_mfma_f32_32x32x16_bf16(pa0, PK(l0, h0), od, 0, 0, 0);
  od = __builtin_amdgcn_mfma_f32_32x32x16_bf16(pa1, PK(l1, h1), od, 0, 0, 0);
  od = __builtin_amdgcn_mfma_f32_32x32x16_bf16(pa2, PK(l2, h2), od, 0, 0, 0);
  od = __builtin_amdgcn_mfma_f32_32x32x16_bf16(pa3, PK(l3, h3), od, 0, 0, 0);
#undef PK
}
__device__ __forceinline__ void pv_d0(f32x16* o, int vb, bf16x8 pa0, bf16x8 pa1, bf16x8 pa2, bf16x8 pa3) {
  pv_one<0>(o[0], vb, pa0, pa1, pa2, pa3); pv_one<1>(o[1], vb, pa0, pa1, pa2, pa3); pv_one<2>(o[2], vb, pa0, pa1, pa2, pa3); pv_one<3>(o[3], vb, pa0, pa1, pa2, pa3);
}
__device__ __forceinline__ void attn_unit(const bf16* __restrict__ Qb, const bf16* __restrict__ Kh, const bf16* __restrict__ Vh, const bf16* __restrict__ Gb, bf16* __restrict__ Yb, int seq, char* lds,
                                          const float* __restrict__ ropetab, const float* __restrict__ qnw, int t0) {
  int tid_ = threadIdx.x; asm volatile("" : "+v"(tid_));
  const int tid = tid_, wid = tid >> 6, lane = tid & 63, r32 = lane & 31, hi = lane >> 5;
  bf16* V_lds = (bf16*)lds; bf16* K_lds = (bf16*)(lds + 2 * SHM_V);
  float* ws = (float*)(lds + 2 * SHM_V + 2 * SHM_K) + wid * 64; float* li_l = ws; float* al_l = ws + 32;
  float m_reg = -1e30f, l_reg = 0; f32x16 o[4] = {}; bf16x8 qr[8];
  const bf16* Qw = Qb + (long)(wid * QBLK + r32) * LDQ + hi * 8;
  const int sr = tid >> 4, sc = (tid & 15) * 8, vst0 = v_st(sr, sc), vst1 = v_st(32 + sr, sc);
  const int vb0 = (int)(uintptr_t)V_lds + v_rd_base(lane);
  struct { bf16x8 vs0, vs1, ks0, ks1; } sr_[SDEPTH];
#define SLOAD(i, k0) do { sr_[i].vs0 = ld8(&Vh[(long)((k0) + sr) * LDK + sc]); sr_[i].vs1 = ld8(&Vh[(long)((k0) + 32 + sr) * LDK + sc]); \
    sr_[i].ks0 = ld8(&Kh[(long)((k0) + sr) * LDK + sc]); sr_[i].ks1 = ld8(&Kh[(long)((k0) + 32 + sr) * LDK + sc]); } while (0)
  constexpr int SE = 0, SO = SDEPTH - 1;
  SLOAD(SE, 0); if constexpr (SDEPTH == 2) SLOAD(SO, KVBLK);
  {
    bf16x8 raw[8]; float ss = 0.f;
#pragma unroll
    for (int d0 = 0; d0 < 8; ++d0) raw[d0] = ld8(Qw + d0 * 16);
#pragma unroll
    for (int d0 = 0; d0 < 8; ++d0)
#pragma unroll
      for (int j = 0; j < 8; ++j) { const float v = __uint_as_float((unsigned)(unsigned short)raw[d0][j] << 16); ss += v * v; }
    { auto rr = __builtin_amdgcn_permlane32_swap(__float_as_uint(ss), __float_as_uint(ss), false, false); ss = __uint_as_float(rr[0]) + __uint_as_float(rr[1]); }
    const float rstd = 1.0f / sqrtf(ss * (1.0f / D) + 1e-6f);
    const int tq = t0 + wid * QBLK + r32;
#pragma unroll
    for (int ax = 0; ax < 2; ++ax) {
      const float* cp = ropetab + (ax ? 32 + (tq & 63) : (tq >> 6)) * 32 + 8 * hi; const float* sp = cp + 96 * 32;
#pragma unroll
      for (int pb = 0; pb < 2; ++pb) {
        const int da = 4 * ax + pb, db = da + 2;
        const float4 c0 = *(const float4*)(cp + 16 * pb), c1 = *(const float4*)(cp + 16 * pb + 4), s0 = *(const float4*)(sp + 16 * pb), s1 = *(const float4*)(sp + 16 * pb + 4);
        const float4 wa0 = *(const float4*)(qnw + 16 * da + 8 * hi), wa1 = *(const float4*)(qnw + 16 * da + 8 * hi + 4), wb0 = *(const float4*)(qnw + 16 * db + 8 * hi), wb1 = *(const float4*)(qnw + 16 * db + 8 * hi + 4);
        const float cc[8] = {c0.x, c0.y, c0.z, c0.w, c1.x, c1.y, c1.z, c1.w}, sn[8] = {s0.x, s0.y, s0.z, s0.w, s1.x, s1.y, s1.z, s1.w};
        const float wa[8] = {wa0.x, wa0.y, wa0.z, wa0.w, wa1.x, wa1.y, wa1.z, wa1.w}, wb[8] = {wb0.x, wb0.y, wb0.z, wb0.w, wb1.x, wb1.y, wb1.z, wb1.w};
        float oa[8], ob[8];
#pragma unroll
        for (int j = 0; j < 8; ++j) { const float a = __uint_as_float((unsigned)(unsigned short)raw[da][j] << 16) * rstd * wa[j], b = __uint_as_float((unsigned)(unsigned short)raw[db][j] << 16) * rstd * wb[j];
          oa[j] = a * cc[j] - b * sn[j]; ob[j] = b * cc[j] + a * sn[j]; }
        u32x4 pa = {cvtpk(oa[0], oa[1]), cvtpk(oa[2], oa[3]), cvtpk(oa[4], oa[5]), cvtpk(oa[6], oa[7])}, pbk = {cvtpk(ob[0], ob[1]), cvtpk(ob[2], ob[3]), cvtpk(ob[4], ob[5]), cvtpk(ob[6], ob[7])};
        qr[da] = *reinterpret_cast<bf16x8*>(&pa); qr[db] = *reinterpret_cast<bf16x8*>(&pbk);
      }
    }
  }
#define SWRITE(b, i) do { *(bf16x8*)((char*)V_lds + (b) * SHM_V + vst0) = sr_[i].vs0;          \
    *(bf16x8*)((char*)V_lds + (b) * SHM_V + vst1) = sr_[i].vs1; int kc = sc * 2;               \
    *(bf16x8*)((char*)K_lds + (b) * SHM_K + KSWZ(sr, kc)) = sr_[i].ks0;                       \
    *(bf16x8*)((char*)K_lds + (b) * SHM_K + KSWZ(32 + sr, kc)) = sr_[i].ks1; } while (0)
#define SWAIT() do { if constexpr (SDEPTH == 2) asm volatile("s_waitcnt vmcnt(4)" ::: "memory"); else asm volatile("s_waitcnt vmcnt(0)" ::: "memory"); } while (0)
#define RESC(a) do { if (__any((a) < 1.f)) { if (hi == 0) al_l[r32] = (a); asm volatile("s_waitcnt lgkmcnt(0)" ::: "memory"); \
    for (int d = 0; d < 4; ++d) for (int r = 0; r < 16; ++r) o[d][r] *= al_l[crow(r, hi)]; } } while (0)
  f32x16 pA0, pA1, pB0, pB1; float mnA, mnB, alA, alB; bf16x8 pa0, pa1, pa2, pa3; const int NT = seq / KVBLK;
  asm volatile("s_waitcnt vmcnt(0)" ::: "memory"); SWRITE(0, SE); __syncthreads();
  qkt(pA0, pA1, K_lds, qr, r32, hi); partialSM(pA0, pA1, m_reg, mnA, alA);
  if constexpr (SDEPTH == 2) { if (2 < NT) SLOAD(SE, 2 * KVBLK); } else SLOAD(SO, KVBLK);
  SWAIT(); SWRITE(1, SO); __syncthreads();
  for (int j = 1; j + 1 < NT; j += 2) {
    SBAR(); qkt(pB0, pB1, (bf16*)((char*)K_lds + SHM_K), qr, r32, hi);
    finishSM(pA0, pA1, alA, l_reg, pa0, pa1, pa2, pa3); SBAR();
    SLOAD(SO, (j + SDEPTH) * KVBLK); SBAR();
    pv_d0(o, vb0, pa0, pa1, pa2, pa3); partialSM(pB0, pB1, m_reg, mnB, alB);
    __syncthreads(); SWAIT(); SWRITE(0, SE);
    RESC(alB); __syncthreads();
    SBAR(); qkt(pA0, pA1, K_lds, qr, r32, hi);
    finishSM(pB0, pB1, alB, l_reg, pa0, pa1, pa2, pa3); SBAR();
    if (SDEPTH == 1 || j + 3 < NT) SLOAD(SE, (j + 1 + SDEPTH) * KVBLK); SBAR();
    pv_d0(o, vb0 + (int)SHM_V, pa0, pa1, pa2, pa3); partialSM(pA0, pA1, m_reg, mnA, alA);
    __syncthreads(); SWAIT(); SWRITE(1, SO);
    RESC(alA); __syncthreads();
  }
  SBAR(); qkt(pB0, pB1, (bf16*)((char*)K_lds + SHM_K), qr, r32, hi);
  finishSM(pA0, pA1, alA, l_reg, pa0, pa1, pa2, pa3); SBAR();
  pv_d0(o, vb0, pa0, pa1, pa2, pa3); partialSM(pB0, pB1, m_reg, mnB, alB);
  __syncthreads(); RESC(alB);
  finishSM(pB0, pB1, alB, l_reg, pa0, pa1, pa2, pa3); SBAR();
  pv_d0(o, vb0 + (int)SHM_V, pa0, pa1, pa2, pa3);
  u32x4 gv[8];
  { const unsigned short* Gw = (const unsigned short*)Gb + (long)(wid * QBLK) * LDO;
#pragma unroll
    for (int i = 0; i < 8; ++i) { const int c = lane + 64 * i, row = c >> 4, ch = c & 15; const unsigned short* gp = Gw + (long)row * LDO + ch * 8;
      asm volatile("global_load_dwordx4 %0, %1, off" : "=v"(gv[i]) : "v"(gp)); } }
  if (hi == 0) li_l[r32] = l_reg; asm volatile("s_waitcnt lgkmcnt(0)" ::: "memory");
  float rli[16];
#pragma unroll
  for (int r = 0; r < 16; ++r) rli[r] = __builtin_amdgcn_rcpf(li_l[crow(r, hi)]);
  unsigned short* ost = (unsigned short*)(lds + SHM_ATTN) + wid * (QBLK * D);
#pragma unroll
  for (int r = 0; r < 16; ++r) { const int orow = crow(r, hi);
#pragma unroll
    for (int d0 = 0; d0 < 4; ++d0) ost[orow * D + d0 * 32 + r32] = (unsigned short)(cvtpk(o[d0][r] * rli[r], 0.f) & 0xffffu); }
  asm volatile("s_waitcnt lgkmcnt(0)" ::: "memory");
  asm volatile("s_waitcnt vmcnt(0)" : "+v"(gv[0]), "+v"(gv[1]), "+v"(gv[2]), "+v"(gv[3]), "+v"(gv[4]), "+v"(gv[5]), "+v"(gv[6]), "+v"(gv[7]) :: "memory");
  unsigned short* Yw = (unsigned short*)Yb + (long)(wid * QBLK) * 64;
#pragma unroll
  for (int hf = 0; hf < 2; ++hf) { u32x4 ov[4];
#pragma unroll
    for (int i = 0; i < 4; ++i) { const int c = lane + 64 * (4 * hf + i), row = c >> 4, ch = c & 15; ov[i] = *(const u32x4*)(ost + row * D + ch * 8); }
#pragma unroll
    for (int i = 0; i < 4; ++i) { const int c = lane + 64 * (4 * hf + i), row = c >> 4, ch = c & 15; u32x4 y;
#pragma unroll
      for (int q = 0; q < 4; ++q) { const float ga = __uint_as_float(gv[4 * hf + i][q] << 16), gb = __uint_as_float(gv[4 * hf + i][q] & 0xffff0000u);
        const float sa = ga * __builtin_amdgcn_rcpf(1.0f + __builtin_amdgcn_exp2f(-1.4426950408889634f * ga)), sb = gb * __builtin_amdgcn_rcpf(1.0f + __builtin_amdgcn_exp2f(-1.4426950408889634f * gb));
        y[q] = cvtpk(__uint_as_float(ov[i][q] << 16) * sa, __uint_as_float(ov[i][q] & 0xffff0000u) * sb); }
      *(u32x4*)(Yw + (long)row * 64 + (ch >> 3) * (256 * 64) + (ch & 7) * 8) = y; }
    asm volatile("" ::: "memory"); }
#undef SLOAD
#undef SWRITE
#undef SWAIT
#undef RESC
}
#undef KSWZ
#undef SBAR
}
constexpr int NWAVES = 8;
#ifndef MK_N_LAUNCHES
#define MK_N_LAUNCHES 1
#endif
constexpr int N_PHASES = 11;
constexpr int N_LAUNCHES = MK_N_LAUNCHES;
static_assert(N_LAUNCHES == 1 || N_LAUNCHES == N_PHASES, "MK_N_LAUNCHES is 1 or N_PHASES");
constexpr int RING_OFF = 0, RING_BYTES = 131072;
constexpr int LDSCTL_OFF = 143360, MISC_OFF = LDSCTL_OFF + 320;
constexpr int LDS_BYTES = 147456;
static_assert(MISC_OFF + 128 <= LDS_BYTES && (int)attn::SHM_TOTAL <= LDSCTL_OFF, "LDS map");

#define GAS __attribute__((address_space(1)))
#define LAS __attribute__((address_space(3)))
typedef unsigned short bf16;
typedef unsigned v4u __attribute__((ext_vector_type(4)));
typedef unsigned v2u __attribute__((ext_vector_type(2)));
typedef float f32x4 __attribute__((ext_vector_type(4)));
typedef GAS unsigned gu32;
#define RLX_AGENT __ATOMIC_RELAXED, __HIP_MEMORY_SCOPE_AGENT
#define LDS_WAIT() asm volatile("s_waitcnt lgkmcnt(0)" ::: "memory")
#define VM_WAIT() asm volatile("s_waitcnt vmcnt(0)" ::: "memory")
__device__ __forceinline__ unsigned f2bf(float f) { unsigned u = __builtin_bit_cast(unsigned, f); return (u + 0x7fffu + ((u >> 16) & 1u)) >> 16; }
__device__ __forceinline__ unsigned pk2(float lo, float hi) { typedef float f32x2_ __attribute__((ext_vector_type(2))); typedef __bf16 bf16x2_ __attribute__((ext_vector_type(2))); f32x2_ v = {lo, hi}; return __builtin_bit_cast(unsigned, __builtin_convertvector(v, bf16x2_)); }
__device__ __forceinline__ float bflo(unsigned w) { return __uint_as_float(w << 16); }
__device__ __forceinline__ float bfhi(unsigned w) { return __uint_as_float(w & 0xffff0000u); }
#define XB_TMO      128
#define XB_XCNT(j)  (256  + 64 * (j))
#define XB_XSUB(j)  (1280 + 64 * (j))
#define XB_XGEN(j)  (2304 + 64 * (j))
#define XB_TOP      3328
#define XB_TOPGEN   3392
#define XCD_BAR_WORDS 3456
#define XB_SPIN_CAP (1u << 18)

__device__ __forceinline__ unsigned xb_ld(unsigned* p)              { return __hip_atomic_load(p, __ATOMIC_RELAXED, __HIP_MEMORY_SCOPE_AGENT); }
__device__ __forceinline__ unsigned xb_add(unsigned* p, unsigned v) { return __hip_atomic_fetch_add(p, v, __ATOMIC_RELAXED, __HIP_MEMORY_SCOPE_AGENT); }
__device__ __forceinline__ unsigned xb_xcc_id() { return (unsigned)__builtin_amdgcn_s_getreg((3 << 11) | 20) & 0xFu; }
#define XB_SPIN(cond, bar) do { unsigned _sp = 0; while (cond) { __builtin_amdgcn_s_sleep(1); \
    if ((++_sp & 255u) == 0u) { if (xb_ld(&(bar)[XB_TMO])) break; if (_sp > XB_SPIN_CAP) { atomicAdd(&(bar)[XB_TMO], 1u); break; } } } } while (0)

struct XcdBarrier {
    unsigned* bar; unsigned x;
    volatile LAS unsigned* st;
};

__device__ __forceinline__ XcdBarrier xcd_barrier_post(unsigned* bar, volatile LAS unsigned* st) {
    XcdBarrier b; b.bar = bar; b.x = xb_xcc_id(); b.st = st;
    if (threadIdx.x == 0) (void)xb_add(&bar[XB_XCNT(b.x)], 1u);
    return b;
}
__device__ __forceinline__ void xcd_barrier_complete(unsigned* bar, unsigned x, unsigned& nloc, unsigned& nx) {
    const unsigned G = gridDim.x * gridDim.y * gridDim.z;
    unsigned sum, cnt, mine, sp = 0u;
    for (;;) {
        sum = 0u; cnt = 0u; mine = 0u;
#pragma unroll
        for (unsigned j = 0; j < 16; ++j) { const unsigned c = xb_ld(&bar[XB_XCNT(j)]); sum += c; cnt += (c > 0u) ? 1u : 0u; mine = (j == x) ? c : mine; }
        if (sum == G) break;
        __builtin_amdgcn_s_sleep(1);
        if ((++sp & 255u) == 0u) { if (xb_ld(&bar[XB_TMO])) break; if (sp > XB_SPIN_CAP) { atomicAdd(&bar[XB_TMO], 1u); break; } }
    }
    nloc = mine > 0u ? mine : 1u; nx = cnt > 0u ? cnt : 1u;
}

__device__ __forceinline__ void xcd_barrier(const XcdBarrier& b) {
    asm volatile("s_waitcnt vmcnt(0)" ::: "memory");
    __syncthreads();
    if (threadIdx.x == 0) {
        unsigned* bar = b.bar;
        __builtin_amdgcn_s_waitcnt(0);
        unsigned nloc = b.st[0], nx = b.st[1];
        if (nloc == 0u) { xcd_barrier_complete(bar, b.x, nloc, nx); b.st[0] = nloc; b.st[1] = nx; }
        const unsigned old = xb_add(&bar[XB_XSUB(b.x)], 1u);
        const unsigned gen = old / nloc;
        if (old + 1u == (gen + 1u) * nloc) {
            __builtin_amdgcn_fence(__ATOMIC_RELEASE, "agent");
            asm volatile("s_waitcnt vmcnt(0)" ::: "memory");
            const unsigned og = xb_add(&bar[XB_TOP], 1u);
            const unsigned tg = og / nx;
            if (og + 1u == (tg + 1u) * nx) xb_add(&bar[XB_TOPGEN], 1u);
            else XB_SPIN(xb_ld(&bar[XB_TOPGEN]) == tg, bar);
            __builtin_amdgcn_fence(__ATOMIC_ACQUIRE, "agent");
            xb_add(&bar[XB_XGEN(b.x)], 1u);
            asm volatile("s_waitcnt vmcnt(0)" ::: "memory");
        } else {
            XB_SPIN(xb_ld(&bar[XB_XGEN(b.x)]) == gen, bar);
            __builtin_amdgcn_fence(__ATOMIC_ACQUIRE, "agent");
            asm volatile("s_waitcnt vmcnt(0)" ::: "memory");
        }
    }
    __syncthreads();
}
struct Frame {
    LAS unsigned char* lds;
    volatile LAS unsigned* MISC;
    gu32* ctl;
    int tid, lane, wave;
    int vcu, G;
    const float *x, *c, *ctx, *c_ctx, *norm_w, *w_ada, *b_ada, *w_in, *q_norm_w, *k_norm_w, *lb_logits, *hg_norm_w, *w_proj_hg, *w_proj_att, *w_out, *final_norm_w;
    float* out; unsigned char* ws;
};
__device__ __forceinline__ float wave_sum(float v) {
#pragma unroll
    for (int o = 1; o < 64; o <<= 1) v += __shfl_xor(v, o);
    return v;
}
__device__ __forceinline__ float sum16(float v) {
    v += __shfl_xor(v, 1); v += __shfl_xor(v, 2); v += __shfl_xor(v, 4); v += __shfl_xor(v, 8); return v;
}
__device__ __forceinline__ float sigmoid_acc(float v) { return 1.0f / (1.0f + expf(-v)); }
__device__ __forceinline__ void sincos_d(double x, double& s, double& c) {
    const double n = rint(x * 0.63661977236758134308);
    double r = fma(-n, 1.5707963267948966192, x); r = fma(-n, 6.123233995736766036e-17, r);
    const double r2 = r * r;
    double ps = -1.0 / 355687428096000.0;
    ps = fma(ps, r2, 1.0 / 1307674368000.0); ps = fma(ps, r2, -1.0 / 6227020800.0); ps = fma(ps, r2, 1.0 / 39916800.0); ps = fma(ps, r2, -1.0 / 362880.0);
    ps = fma(ps, r2, 1.0 / 5040.0); ps = fma(ps, r2, -1.0 / 120.0); ps = fma(ps, r2, 1.0 / 6.0); ps = -ps;
    const double sr = fma(r * r2, ps, r);
    double pc = 1.0 / 20922789888000.0;
    pc = fma(pc, r2, -1.0 / 87178291200.0); pc = fma(pc, r2, 1.0 / 479001600.0); pc = fma(pc, r2, -1.0 / 3628800.0); pc = fma(pc, r2, 1.0 / 40320.0);
    pc = fma(pc, r2, -1.0 / 720.0); pc = fma(pc, r2, 1.0 / 24.0); pc = fma(pc, r2, -0.5);
    const double cr = fma(pc, r2, 1.0);
    const int q = ((int)n) & 3;
    s = (q == 0) ? sr : (q == 1) ? cr : (q == 2) ? -sr : -cr;
    c = (q == 0) ? cr : (q == 1) ? -sr : (q == 2) ? -cr : sr;
}
constexpr int ADA_ITEMS = 4 * (NADA / 32);
__device__ __forceinline__ void p0_prologue(Frame& F) {
    const int gw = F.vcu * NWAVES + F.wave, NGW = F.G * NWAVES;
    float* tab = (float*)(F.ws + WS_TAB);
    if (F.vcu == F.G - 1) {
        for (int i = F.tid; i < 96 * 32; i += NWAVES * 64) { const int p = i >> 5, f = i & 31; const double pos = (double)(p < 32 ? p : p - 32);
            const double inv = exp(-(double)f * (9.2103403719761836 / 32.0));
            double s, c; sincos_d(pos * inv, s, c); tab[i] = (float)c; tab[96 * 32 + i] = (float)s; }
        float* lb = (float*)(F.ws + WS_TAB + TAB_LB);
        for (int i = F.tid; i < 2 * DM; i += NWAVES * 64) { const int d = i >> 12, k = i & 4095; const float a0 = F.lb_logits[(d * 2 + 0) * DM + k], a1 = F.lb_logits[(d * 2 + 1) * DM + k];
            lb[i] = 1.0f / (1.0f + expf(a1 - a0)); }
    }
    if (gw - F.wave < ADA_ITEMS) {
        LAS float* sl = (LAS float*)(F.lds + RING_OFF);
        for (int i = F.tid; i < 5 * DM; i += NWAVES * 64) { const float v = i < 4 * DM ? F.c[i] : F.c_ctx[i - 4 * DM]; sl[i] = v * sigmoid_acc(v); }
        __syncthreads();
        float* slab = (float*)(F.ws + WS_MODP);
        for (int item = gw; item < ADA_ITEMS; item += NGW) {
            const int kq = item / (NADA / 32), n0 = (item % (NADA / 32)) * 32, rq = F.lane >> 3, cq = F.lane & 7, kbase = kq * 1024;
            f32x4 acc[5];
#pragma unroll
            for (int b = 0; b < 5; ++b) acc[b] = (f32x4){0.f, 0.f, 0.f, 0.f};
            const float* wp = F.w_ada + (size_t)(kbase + rq) * NADA + n0 + 4 * cq;
            for (int it = 0; it < 128; it += 8) {
                f32x4 w[8];
#pragma unroll
                for (int u = 0; u < 8; ++u) w[u] = __builtin_nontemporal_load((const f32x4*)(wp + (size_t)(it + u) * 8 * NADA));
#pragma unroll
                for (int u = 0; u < 8; ++u) { const int k = kbase + (it + u) * 8 + rq;
#pragma unroll
                    for (int b = 0; b < 5; ++b) acc[b] += sl[b * DM + k] * w[u]; }
            }
#pragma unroll
            for (int b = 0; b < 5; ++b)
#pragma unroll
                for (int j = 0; j < 4; ++j) { float v = acc[b][j]; v += __shfl_xor(v, 8); v += __shfl_xor(v, 16); v += __shfl_xor(v, 32); acc[b][j] = v; }
            if (rq == 0) {
#pragma unroll
                for (int b = 0; b < 5; ++b) *(f32x4*)(slab + ((size_t)kq * 5 + b) * NADA + n0 + 4 * cq) = acc[b]; }
        }
        __syncthreads();
    }
}
__device__ __forceinline__ void p1_modulate(Frame& F) {
    const float* slab = (const float*)(F.ws + WS_MODP);
    if (F.vcu < 32) {
        const int idx = F.vcu * 512 + F.tid, b = idx >> 12, c = idx & 4095; float g = F.b_ada[2 * DM + c];
#pragma unroll
        for (int s = 0; s < 4; ++s) g += slab[((size_t)s * 5 + b) * NADA + 2 * DM + c];
        ((float*)(F.ws + WS_TAB + TAB_GATE))[idx] = g;
    }
    LAS float* cA = (LAS float*)(F.lds + RING_OFF); LAS float* cS = cA + DM;
    const int r_lo = (int)((long)F.vcu * MH / F.G), r_hi = (int)((long)(F.vcu + 1) * MH / F.G);
    int seg_lo = r_lo;
    while (seg_lo < r_hi) {
        const int bid = seg_lo < MX ? seg_lo / T : 4;
        const int bend = bid < 4 ? (bid + 1) * T : MH;
        const int seg_hi = r_hi < bend ? r_hi : bend;
        __syncthreads();
        for (int k = F.tid; k < DM; k += NWAVES * 64) { float sh = F.b_ada[k], sc = F.b_ada[DM + k];
#pragma unroll
            for (int s = 0; s < 4; ++s) { sh += slab[((size_t)s * 5 + bid) * NADA + k]; sc += slab[((size_t)s * 5 + bid) * NADA + DM + k]; }
            cA[k] = F.norm_w[k] * (1.0f + sc); cS[k] = sh; }
        __syncthreads();
        for (int row = seg_lo + F.wave; row < seg_hi; row += NWAVES) {
            const float* xr = row < MX ? F.x + (size_t)row * DM : F.ctx + (size_t)(row - MX) * DM;
            const GAS f32x4* xp = (const GAS f32x4*)xr + F.lane;
            f32x4 v[16]; float ss = 0.f;
#pragma unroll
            for (int j = 0; j < 16; ++j) { v[j] = __builtin_nontemporal_load(xp + 64 * j); ss += (v[j].x * v[j].x + v[j].y * v[j].y) + (v[j].z * v[j].z + v[j].w * v[j].w); }
            const float rstd = 1.0f / sqrtf(wave_sum(ss) * (1.0f / DM) + EPS);
            GAS v2u* op = (GAS v2u*)((bf16*)(F.ws + WS_H) + (size_t)(row >> 8) * (DM / 64) * (256 * 64) + (row & 255) * 64 + (F.lane >> 4) * (256 * 64)) + (F.lane & 15);
#pragma unroll
            for (int j = 0; j < 16; ++j) { const f32x4 a = *(const LAS f32x4*)(cA + 4 * (64 * j + F.lane)), s = *(const LAS f32x4*)(cS + 4 * (64 * j + F.lane));
                const f32x4 h = v[j] * rstd * a + s; v2u o; o.x = pk2(h.x, h.y); o.y = pk2(h.z, h.w); *op = o; op += 4 * 256 * 64 / 4;
                if ((j & 3) == 3) asm volatile("" ::: "memory"); }
        }
        seg_lo = seg_hi;
    }
}
template <int N> __device__ __forceinline__ void conv_issue(const float* W, int item, int lane, f32x4 (&a)[16]) {
    const int kb = item / (N / 64), nb = item % (N / 64);
    const float* p = W + (size_t)(64 * kb + 2 * (lane >> 4)) * N + 64 * nb + 4 * (lane & 15);
#pragma unroll
    for (int i = 0; i < 16; ++i) { const float* q = p + (size_t)(8 * (i >> 1) + (i & 1)) * N; asm volatile("global_load_dwordx4 %0, %1, off nt" : "=v"(a[i]) : "v"(q)); }
}
#define CONV_OPS(X) "+v"(X[0]), "+v"(X[1]), "+v"(X[2]), "+v"(X[3]), "+v"(X[4]), "+v"(X[5]), "+v"(X[6]), "+v"(X[7]), "+v"(X[8]), "+v"(X[9]), "+v"(X[10]), "+v"(X[11]), "+v"(X[12]), "+v"(X[13]), "+v"(X[14]), "+v"(X[15])
__device__ __forceinline__ void conv_wait(f32x4 (&a)[16]) { asm volatile("s_waitcnt vmcnt(16)" : CONV_OPS(a) :: "memory"); }
__device__ __forceinline__ void conv_drain(f32x4 (&a)[16], f32x4 (&b)[16]) { asm volatile("s_waitcnt vmcnt(0)" : CONV_OPS(a) :: "memory"); asm volatile("" : CONV_OPS(b) :: "memory"); }
template <int N> __device__ __forceinline__ void conv_emit(bf16* WT, int item, int lane, LAS unsigned char* scr, const f32x4 (&a)[16]) {
    const int kb = item / (N / 64), nb = item % (N / 64), rg = lane >> 4, cn = lane & 15;
#pragma unroll
    for (int p_ = 0; p_ < 8; ++p_)
#pragma unroll
        for (int j = 0; j < 4; ++j) *(LAS unsigned*)(scr + (4 * cn + j) * 136 + (8 * p_ + 2 * rg) * 2) = pk2(a[2 * p_][j], a[2 * p_ + 1][j]);
    LDS_WAIT(); asm volatile("" ::: "memory");
    bf16* dst = WT + ((size_t)(nb >> 2) * (DM / 64) + kb) * (256 * 64) + (nb & 3) * (64 * 64) + lane * 8;
#pragma unroll
    for (int jj = 0; jj < 8; ++jj) { const LAS unsigned char* s_ = scr + (8 * jj + (lane >> 3)) * 136 + 16 * (lane & 7);
        const v2u lo = *(const LAS v2u*)s_, hi = *(const LAS v2u*)(s_ + 8); v4u o; o.x = lo.x; o.y = lo.y; o.z = hi.x; o.w = hi.y;
        *(GAS v4u*)(dst + jj * 512) = o; }
    LDS_WAIT(); asm volatile("" ::: "memory");
}
template <int N> __device__ __forceinline__ void conv_stream(const float* W, bf16* WT, int first, int step, int lane, LAS unsigned char* scr) {
    constexpr int NI = (DM / 64) * (N / 64);
    if (first >= NI) return;
    f32x4 A[16], B[16];
    int it = first; conv_issue<N>(W, it, lane, A);
    for (; it < NI; it += 2 * step) { const int i2 = it + step, i3 = it + 2 * step;
        conv_issue<N>(W, i2 < NI ? i2 : it, lane, B); conv_wait(A); conv_emit<N>(WT, it, lane, scr, A);
        conv_issue<N>(W, i3 < NI ? i3 : it, lane, A); conv_wait(B); if (i2 < NI) conv_emit<N>(WT, i2, lane, scr, B); }
    conv_drain(A, B);
}
__device__ __forceinline__ void p0c_convert(Frame& F) {
    const int gw = F.vcu * NWAVES + F.wave, NGW = F.G * NWAVES;
    __syncthreads();
    LAS unsigned char* scr = (LAS unsigned char*)(F.lds + RING_OFF + F.wave * 16384);
    conv_stream<NIN>(F.w_in, (bf16*)(F.ws + WS_WIN), gw, NGW, F.lane, scr);
    conv_stream<DM>(F.w_proj_hg, (bf16*)(F.ws + WS_WPH), gw, NGW, F.lane, scr);
    if (F.G != 256) { conv_stream<DM>(F.w_proj_att, (bf16*)(F.ws + WS_WPA), gw, NGW, F.lane, scr); conv_stream<DM>(F.w_out, (bf16*)(F.ws + WS_WO), gw, NGW, F.lane, scr); }
}
__device__ __forceinline__ void p2_tail_convert(Frame& F, int idx) {
    LAS unsigned char* scr = (LAS unsigned char*)(F.lds + RING_OFF + F.wave * 16384);
    conv_stream<DM>(F.w_proj_att, (bf16*)(F.ws + WS_WPA), idx * NWAVES + F.wave, 32 * NWAVES, F.lane, scr);
    conv_stream<DM>(F.w_out, (bf16*)(F.ws + WS_WO), idx * NWAVES + F.wave, 32 * NWAVES, F.lane, scr);
}
__device__ __forceinline__ void p3_qk_norm_rope(Frame& F) {
    const int gw = F.vcu * NWAVES + F.wave, NGW = F.G * NWAVES;
    const float* tab = (const float*)(F.ws + WS_TAB);
    const int e = F.lane & 15, hl = F.lane >> 4;
    for (int it = gw; it < BATCH * NKV * (SKV / 4); it += NGW) {
        const int bh = it / (SKV / 4), pos = (it % (SKV / 4)) * 4 + hl, t = pos - LCTX;
        bf16* p = (bf16*)(F.ws + WS_KALL) + ((size_t)bh * SKV + pos) * HD + 8 * e; const float* w = F.k_norm_w;
        const v4u raw = *(const GAS v4u*)p;
        float y[8] = {bflo(raw.x), bfhi(raw.x), bflo(raw.y), bfhi(raw.y), bflo(raw.z), bfhi(raw.z), bflo(raw.w), bfhi(raw.w)};
        float ss = 0.f;
#pragma unroll
        for (int j = 0; j < 8; ++j) ss += y[j] * y[j];
        const float rstd = 1.0f / sqrtf(sum16(ss) * (1.0f / HD) + EPS);
        const f32x4 w0 = *(const f32x4*)(w + 8 * e), w1 = *(const f32x4*)(w + 8 * e + 4);
#pragma unroll
        for (int j = 0; j < 8; ++j) y[j] = y[j] * rstd * (j < 4 ? w0[j] : w1[j - 4]);
        if (t >= 0) {
            const int posi = (e >> 3) ? 32 + (t & 63) : (t >> 6);
            const float* cp = tab + posi * 32 + 8 * (e & 3); const float* sp = cp + 96 * 32;
            const f32x4 c0 = *(const f32x4*)cp, c1 = *(const f32x4*)(cp + 4), s0 = *(const f32x4*)sp, s1 = *(const f32x4*)(sp + 4);
            const float sgn = ((e >> 2) & 1) ? 1.0f : -1.0f;
#pragma unroll
            for (int j = 0; j < 8; ++j) { const float pr = __shfl_xor(y[j], 4); const float cc = j < 4 ? c0[j] : c1[j - 4], sn = j < 4 ? s0[j] : s1[j - 4]; y[j] = y[j] * cc + sgn * pr * sn; }
        }
        v4u o; o.x = pk2(y[0], y[1]); o.y = pk2(y[2], y[3]); o.z = pk2(y[4], y[5]); o.w = pk2(y[6], y[7]);
        *(GAS v4u*)p = o;
    }
}
__device__ __forceinline__ int hg_posof(int n, int i, int dir) {
    if (n < 8) { const int pos = 32 * n + i; return dir ? LCTX - 1 - pos : pos; }
    const int pos = 32 * (n - 8) + i; return LCTX + (dir ? T - 1 - pos : pos);
}
__device__ __forceinline__ void p5_attention(Frame& F, int nkeys = SKV) {
    const attn::bf16* Q = (const attn::bf16*)(F.ws + WS_QATT); const attn::bf16* K = (const attn::bf16*)(F.ws + WS_KALL); const attn::bf16* V = (const attn::bf16*)(F.ws + WS_VALL);
    const attn::bf16* Gt = (const attn::bf16*)(F.ws + WS_GATT); attn::bf16* Y = (attn::bf16*)(F.ws + WS_YATT);
    for (int u = F.vcu; u < BATCH * NH * (T / 256); u += F.G) {
        const int grp = u >> 5, j = u & 31, b = grp >> 3, kvh = grp & 7, h = kvh * 4 + (j >> 3), qb = j & 7;
        const size_t qo = ((size_t)(b * NH + h) * T + qb * 256) * HD, ko = (size_t)(b * NKV + kvh) * SKV * HD;
        attn::attn_unit(Q + qo, K + ko, V + ko, Gt + qo, Y + tm_off(b * T + qb * 256, h * HD), nkeys, (char*)(F.lds + RING_OFF), (const float*)(F.ws + WS_TAB), F.q_norm_w, qb * 256);
    }
}
__device__ __forceinline__ void p6_hgrn_out(Frame& F) {
    const int gw = F.vcu * NWAVES + F.wave, NGW = F.G * NWAVES, e = F.lane & 15, tl = F.lane >> 4;
    typedef _Float16 f16x8 __attribute__((ext_vector_type(8)));
    const _Float16* Of = (const _Float16*)(F.ws + WS_OF); const _Float16* Ob = (const _Float16*)(F.ws + WS_OB); const bf16* Gh = (const bf16*)(F.ws + WS_GHG); bf16* Y = (bf16*)(F.ws + WS_YHG);
    for (int it = gw; it < BATCH * NH * (T / 4); it += NGW) {
        const int bh = it / (T / 4), t = (it % (T / 4)) * 4 + tl, b = bh >> 5, hh = bh & 31; const size_t o = ((size_t)bh * T + t) * HD + 8 * e;
        const f16x8 fa = __builtin_nontemporal_load((const f16x8*)(Of + o)), fb = __builtin_nontemporal_load((const f16x8*)(Ob + o));
        const f32x4 a0 = {(float)fa[0], (float)fa[1], (float)fa[2], (float)fa[3]}, a1 = {(float)fa[4], (float)fa[5], (float)fa[6], (float)fa[7]};
        const f32x4 b0 = {(float)fb[0], (float)fb[1], (float)fb[2], (float)fb[3]}, b1 = {(float)fb[4], (float)fb[5], (float)fb[6], (float)fb[7]};
        const v4u g = __builtin_nontemporal_load((const v4u*)(Gh + o)); const f32x4 w0 = *(const f32x4*)(F.hg_norm_w + hh * HD + 8 * e), w1 = *(const f32x4*)(F.hg_norm_w + hh * HD + 8 * e + 4);
        const f32x4 y0 = a0 + b0, y1 = a1 + b1;
        const float ss = (y0.x * y0.x + y0.y * y0.y) + (y0.z * y0.z + y0.w * y0.w) + (y1.x * y1.x + y1.y * y1.y) + (y1.z * y1.z + y1.w * y1.w);
        const float rstd = 1.0f / sqrtf(sum16(ss) * (1.0f / HD) + EPS);
        float gs[8] = {bflo(g.x), bfhi(g.x), bflo(g.y), bfhi(g.y), bflo(g.z), bfhi(g.z), bflo(g.w), bfhi(g.w)};
#pragma unroll
        for (int j = 0; j < 8; ++j) gs[j] = gs[j] * __builtin_amdgcn_rcpf(1.0f + __builtin_amdgcn_exp2f(-1.4426950408889634f * gs[j]));
        v4u r; r.x = pk2(y0.x * rstd * w0.x * gs[0], y0.y * rstd * w0.y * gs[1]); r.y = pk2(y0.z * rstd * w0.z * gs[2], y0.w * rstd * w0.w * gs[3]);
        r.z = pk2(y1.x * rstd * w1.x * gs[4], y1.y * rstd * w1.y * gs[5]); r.w = pk2(y1.z * rstd * w1.z * gs[6], y1.w * rstd * w1.w * gs[7]);
        *(v4u*)(Y + tm_off(b * T + t, hh * HD + 8 * e)) = r;
    }
}
__device__ __forceinline__ void p10_final_norm(Frame& F) {
    const int gw = F.vcu * NWAVES + F.wave, NGW = F.G * NWAVES;
    for (int row = gw; row < MX; row += NGW) {
        GAS f32x4* xp = (GAS f32x4*)(F.out + (size_t)row * DM) + F.lane;
        f32x4 v[16]; float ss = 0.f;
#pragma unroll
        for (int j = 0; j < 16; ++j) { v[j] = xp[64 * j]; ss += (v[j].x * v[j].x + v[j].y * v[j].y) + (v[j].z * v[j].z + v[j].w * v[j].w); }
        const float rstd = 1.0f / sqrtf(wave_sum(ss) * (1.0f / DM) + EPS);
#pragma unroll
        for (int j = 0; j < 16; ++j) { const f32x4 w = *((const f32x4*)F.final_norm_w + 64 * j + F.lane); xp[64 * j] = v[j] * rstd * w; }
    }
}
namespace hg {
typedef short bf16x8 __attribute__((ext_vector_type(8)));
typedef short s16x4 __attribute__((ext_vector_type(4)));
typedef short v4i16_t __attribute__((ext_vector_type(4)));
typedef float f32x16 __attribute__((ext_vector_type(16)));
typedef float f32x2 __attribute__((ext_vector_type(2)));
typedef __bf16 bf16x2_t __attribute__((ext_vector_type(2)));
typedef LAS const char* lds_cptr;
constexpr int QS = 264;
constexpr int OFF_QE = 0, OFF_KE = 32 * QS, OFF_KD = 2 * 32 * QS, OFF_V = OFF_KD + 8192, OFF_DEC = OFF_V + 8192, BUF = OFF_DEC + 512;
__device__ __forceinline__ unsigned cvtpk(float lo, float hi) { f32x2 v = {lo, hi}; bf16x2_t b = __builtin_convertvector(v, bf16x2_t); return __builtin_bit_cast(unsigned, b); }
template <int S_> __device__ __forceinline__ bf16x8 pack_step(const f32x16& x) {
    v4u p = {cvtpk(x[8 * S_], x[8 * S_ + 1]), cvtpk(x[8 * S_ + 2], x[8 * S_ + 3]), cvtpk(x[8 * S_ + 4], x[8 * S_ + 5]), cvtpk(x[8 * S_ + 6], x[8 * S_ + 7])};
    return __builtin_bit_cast(bf16x8, p);
}
__device__ __forceinline__ s16x4 trd(lds_cptr p) { return __builtin_bit_cast(s16x4, __builtin_amdgcn_ds_read_tr16_b64_v4i16((LAS v4i16_t*)p)); }
__device__ __forceinline__ s16x4 ld8(lds_cptr p) { return *(const LAS s16x4*)p; }
__device__ __forceinline__ bf16x8 cat(s16x4 a, s16x4 b) { return __builtin_shufflevector(a, b, 0, 1, 2, 3, 4, 5, 6, 7); }
#define HG_MFMA(a, b, c) __builtin_amdgcn_mfma_f32_32x32x16_bf16((a), (b), (c), 0, 0, 0)
typedef _Float16 f16x2 __attribute__((ext_vector_type(2)));
struct Raw { unsigned g[8]; unsigned q[8]; v4u v0, v1; };
struct Ctx { const _Float16* Gsrc; const bf16* Qsrc; const bf16* Vsrc; _Float16* Odst; int dir; LAS unsigned char* lds; int lane, wave; float lb0, lb1, om0, om1; };
#define HG_GLD32(dst, ptr, off) asm volatile("global_load_dword %0, %1, off offset:%2" : "=v"(dst) : "v"(ptr), "i"(off))
#define HG_GLD128(dst, ptr, off) asm volatile("global_load_dwordx4 %0, %1, off offset:%2" : "=v"(dst) : "v"(ptr), "i"(off))
template <int SGN> __device__ __forceinline__ void load_raw_dir(const Ctx& C, Raw& R, int n_) {
    const int n = n_ < 72 ? n_ : 71;
    const int pw = C.wave - 4, rg = C.lane >> 4, cp = C.lane & 15, tp = pw * 64 + C.lane;
    const int p0 = hg_posof(n, 0, SGN < 0);
    const int o = (p0 + SGN * 8 * rg) * HD + 32 * pw + 2 * cp;
    const _Float16* gp = C.Gsrc + o; const bf16* qp = C.Qsrc + (n >= 8 ? o - LCTX * HD : 8 * rg * HD + 32 * pw + 2 * cp);
#define HG_ROW(r) HG_GLD32(R.g[r], gp, SGN * 256 * (r)); HG_GLD32(R.q[r], qp, (SGN < 0 ? -256 : 256) * (r))
    HG_ROW(0); HG_ROW(1); HG_ROW(2); HG_ROW(3); HG_ROW(4); HG_ROW(5); HG_ROW(6); HG_ROW(7);
#undef HG_ROW
    const bf16* vp = C.Vsrc + (p0 + SGN * (tp >> 3)) * HD + 16 * (tp & 7); HG_GLD128(R.v0, vp, 0); HG_GLD128(R.v1, vp, 16);
}
__device__ __forceinline__ void load_raw(const Ctx& C, Raw& R, int n) { if (C.dir) load_raw_dir<-1>(C, R, n); else load_raw_dir<1>(C, R, n); }
__device__ __forceinline__ void wait_raw(Raw& R) {
    asm volatile("s_waitcnt vmcnt(18)" : "+v"(R.g[0]), "+v"(R.g[1]), "+v"(R.g[2]), "+v"(R.g[3]), "+v"(R.g[4]), "+v"(R.g[5]), "+v"(R.g[6]), "+v"(R.g[7]),
                 "+v"(R.q[0]), "+v"(R.q[1]), "+v"(R.q[2]), "+v"(R.q[3]), "+v"(R.q[4]), "+v"(R.q[5]), "+v"(R.q[6]), "+v"(R.q[7]), "+v"(R.v0), "+v"(R.v1));
}
__device__ __forceinline__ void emit_tiles(const Ctx& C, const Raw& R, int buf, bool lat) {
    const int pw = C.wave - 4, rg = C.lane >> 4, cp = C.lane & 15, tp = pw * 64 + C.lane;
    LAS unsigned char* bb = C.lds + buf * BUF;
    float g0[8], g1[8], f0a[8], f1a[8], c0 = 1.f, c1 = 1.f;
#pragma unroll
    for (int r = 0; r < 8; ++r) { const f16x2 zz = __builtin_bit_cast(f16x2, R.g[r]);
        const float s0 = __builtin_amdgcn_rcpf(1.0f + __builtin_amdgcn_exp2f(-1.4426950408889634f * (float)zz.x)), s1 = __builtin_amdgcn_rcpf(1.0f + __builtin_amdgcn_exp2f(-1.4426950408889634f * (float)zz.y));
        const float f0 = C.lb0 + C.om0 * s0, f1 = C.lb1 + C.om1 * s1;
        c0 *= f0; c1 *= f1; g0[r] = c0; g1[r] = c1; f0a[r] = f0; f1a[r] = f1; }
    float base0, base1, tot0, tot1;
    { const auto a0 = __builtin_amdgcn_permlane16_swap(__float_as_uint(c0), __float_as_uint(c0), false, false), a1 = __builtin_amdgcn_permlane16_swap(__float_as_uint(c1), __float_as_uint(c1), false, false);
      const float p0 = __uint_as_float(a0[0] == __float_as_uint(c0) ? a0[1] : a0[0]), p1 = __uint_as_float(a1[0] == __float_as_uint(c1) ? a1[1] : a1[0]);
      const float s0 = c0 * p0, s1 = c1 * p1; base0 = (rg & 1) ? p0 : 1.f; base1 = (rg & 1) ? p1 : 1.f;
      const auto b0 = __builtin_amdgcn_permlane32_swap(__float_as_uint(s0), __float_as_uint(s0), false, false), b1 = __builtin_amdgcn_permlane32_swap(__float_as_uint(s1), __float_as_uint(s1), false, false);
      const float q0 = __uint_as_float(b0[0] == __float_as_uint(s0) ? b0[1] : b0[0]), q1 = __uint_as_float(b1[0] == __float_as_uint(s1) ? b1[1] : b1[0]);
      tot0 = s0 * q0; tot1 = s1 * q1; if (rg & 2) { base0 *= q0; base1 *= q1; } }
    const float eb0 = tot0, eb1 = tot1;
    float i0 = __builtin_amdgcn_rcpf(base0 * g0[7]), i1 = __builtin_amdgcn_rcpf(base1 * g1[7]);
#pragma unroll
    for (int r = 7; r >= 0; --r) { const int i = 8 * rg + r;
        const float e0 = base0 * g0[r], e1 = base1 * g1[r];
        const float ke0 = (1.0f - f0a[r]) * i0, ke1 = (1.0f - f1a[r]) * i1;
        const unsigned qq = lat ? R.q[r] : 0u;
        *(LAS unsigned*)(bb + OFF_QE + i * QS + (32 * pw + 2 * cp) * 2) = cvtpk(bflo(qq) * e0, bfhi(qq) * e1);
        *(LAS unsigned*)(bb + OFF_KE + i * QS + (32 * pw + 2 * cp) * 2) = cvtpk(ke0, ke1);
        *(LAS unsigned*)(bb + OFF_KD + pw * 2048 + i * 64 + 4 * cp) = cvtpk(ke0 * eb0, ke1 * eb1);
        i0 *= f0a[r]; i1 *= f1a[r]; }
    if (rg == 0) *(LAS f32x2*)(bb + OFF_DEC + (32 * pw + 2 * cp) * 4) = (f32x2){eb0, eb1};
    { const int row = tp >> 3, seg = tp & 7; LAS unsigned char* d = bb + OFF_V + (seg >> 1) * 2048 + row * 64 + (seg & 1) * 32; *(LAS v4u*)d = R.v0; *(LAS v4u*)(d + 16) = R.v1; }
}
__device__ __forceinline__ void consume(const Ctx& C, f32x16 (&S)[4], int n, int buf) {
    const int lane = C.lane, vb = C.wave, r = lane & 31, h = lane >> 5, g = (lane >> 4) & 1, q = (lane & 15) >> 2, p = lane & 3;
    lds_cptr bb = (lds_cptr)(C.lds + buf * BUF);
    lds_cptr trb = bb + (4 * h + q) * 64 + 32 * g + 8 * p;
    const bool lat = n >= 8;
    bf16x8 vf0, vf1;
    { lds_cptr vp = trb + OFF_V + vb * 2048; vf0 = cat(trd(vp), trd(vp + 8 * 64)); vf1 = cat(trd(vp + 16 * 64), trd(vp + 24 * 64)); }
    if (lat) {
        lds_cptr qp = bb + OFF_QE + r * QS + 8 * h, kp = bb + OFF_KE + r * QS + 8 * h;
        bf16x8 qf[8], kf[8];
#pragma unroll
        for (int f = 0; f < 8; ++f) { qf[f] = cat(ld8(qp + f * 32), ld8(qp + f * 32 + 16)); kf[f] = cat(ld8(kp + f * 32), ld8(kp + f * 32 + 16)); }
        __builtin_amdgcn_sched_barrier(0);
        f32x16 oacc, at;
#pragma unroll
        for (int i = 0; i < 16; ++i) { oacc[i] = 0.f; at[i] = 0.f; }
#pragma unroll
        for (int kb = 0; kb < 4; ++kb) {
            const bf16x8 s0 = pack_step<0>(S[kb]), s1 = pack_step<1>(S[kb]);
            oacc = HG_MFMA(qf[2 * kb], s0, oacc); at = HG_MFMA(kf[2 * kb], qf[2 * kb], at);
            oacc = HG_MFMA(qf[2 * kb + 1], s1, oacc); at = HG_MFMA(kf[2 * kb + 1], qf[2 * kb + 1], at);
        }
        __builtin_amdgcn_sched_barrier(0);
#pragma unroll
        for (int i = 0; i < 16; ++i) { const int j = (i & 3) + 8 * (i >> 2) + 4 * h; at[i] = j <= r ? at[i] : 0.f; }
        oacc = HG_MFMA(pack_step<0>(at), vf0, oacc); oacc = HG_MFMA(pack_step<1>(at), vf1, oacc);
        _Float16* op = C.Odst + (hg_posof(n, 4 * h, C.dir) - LCTX) * HD + 32 * vb + r;
        if (C.dir) {
#pragma unroll
            for (int i = 0; i < 16; ++i) op[-((i & 3) + 8 * (i >> 2)) * HD] = (_Float16)oacc[i];
        } else {
#pragma unroll
            for (int i = 0; i < 16; ++i) op[((i & 3) + 8 * (i >> 2)) * HD] = (_Float16)oacc[i];
        }
    }
    bf16x8 kd0[4], kd1[4];
#pragma unroll
    for (int kb = 0; kb < 4; ++kb) { lds_cptr kdp = trb + OFF_KD + kb * 2048; kd0[kb] = cat(trd(kdp), trd(kdp + 8 * 64)); kd1[kb] = cat(trd(kdp + 16 * 64), trd(kdp + 24 * 64)); }
    f32x4 dq[4];
    { lds_cptr dp = bb + OFF_DEC + (4 * h) * 4;
#pragma unroll
      for (int gq = 0; gq < 4; ++gq) dq[gq] = *(const LAS f32x4*)(dp + gq * 32); }
    __builtin_amdgcn_sched_barrier(0);
#pragma unroll
    for (int kb = 0; kb < 4; ++kb) {
        f32x4 dn[4];
        if (kb < 3) { lds_cptr dp = bb + OFF_DEC + (32 * (kb + 1) + 4 * h) * 4;
#pragma unroll
            for (int gq = 0; gq < 4; ++gq) dn[gq] = *(const LAS f32x4*)(dp + gq * 32); }
#pragma unroll
        for (int gq = 0; gq < 4; ++gq)
#pragma unroll
            for (int j = 0; j < 4; ++j) S[kb][4 * gq + j] *= dq[gq][j];
        S[kb] = HG_MFMA(kd0[kb], vf0, S[kb]); S[kb] = HG_MFMA(kd1[kb], vf1, S[kb]);
        if (kb < 3) {
#pragma unroll
            for (int gq = 0; gq < 4; ++gq) dq[gq] = dn[gq]; }
    }
}
#define HG_RAW_OPS(R) "+v"(R.g[0]), "+v"(R.g[1]), "+v"(R.g[2]), "+v"(R.g[3]), "+v"(R.g[4]), "+v"(R.g[5]), "+v"(R.g[6]), "+v"(R.g[7]), "+v"(R.q[0]), "+v"(R.q[1]), "+v"(R.q[2]), "+v"(R.q[3]), "+v"(R.q[4]), "+v"(R.q[5]), "+v"(R.q[6]), "+v"(R.q[7]), "+v"(R.v0), "+v"(R.v1)
__device__ __forceinline__ void drain_raw(Raw& A, Raw& B, Raw& C_) {
    asm volatile("s_waitcnt vmcnt(0)" : HG_RAW_OPS(A) :: "memory"); asm volatile("" : HG_RAW_OPS(B) :: "memory"); asm volatile("" : HG_RAW_OPS(C_) :: "memory");
}
#define HG_BAR() do { asm volatile("s_waitcnt lgkmcnt(0)" ::: "memory"); __builtin_amdgcn_s_barrier(); asm volatile("" ::: "memory"); } while (0)
__device__ __forceinline__ void phase(Frame& F) {
    for (int s = F.vcu; s < 2 * BATCH * NH; s += F.G) {
        Ctx C; C.dir = s & 1; C.lds = F.lds + RING_OFF; C.lane = F.lane; C.wave = F.wave;
        { const int bh = s >> 1;
          C.Gsrc = (const _Float16*)(F.ws + (C.dir ? WS_FB : WS_FF)) + (size_t)bh * SKV * HD; C.Vsrc = (const bf16*)(F.ws + WS_VHG) + (size_t)bh * SKV * HD;
          C.Qsrc = (const bf16*)(F.ws + WS_QHG) + (size_t)bh * T * HD; C.Odst = (_Float16*)(F.ws + (C.dir ? WS_OB : WS_OF)) + (size_t)bh * T * HD;
          const f32x2 lbv = *(const f32x2*)((const float*)(F.ws + WS_TAB + TAB_LB) + C.dir * DM + (bh & (NH - 1)) * HD + 32 * (F.wave & 3) + 2 * (F.lane & 15)); C.lb0 = lbv.x; C.lb1 = lbv.y; C.om0 = 1.0f - lbv.x; C.om1 = 1.0f - lbv.y; }
        if (F.wave >= 4) {
            Raw RA, RB, RC; load_raw(C, RA, 0); load_raw(C, RB, 1);
            for (int t = 0; t < 75; t += 3) {
                wait_raw(RA); load_raw(C, RC, t + 2); if (t < 72) emit_tiles(C, RA, t & 1, t >= 8);
                HG_BAR();
                wait_raw(RB); load_raw(C, RA, t + 3); if (t + 1 < 72) emit_tiles(C, RB, (t + 1) & 1, t + 1 >= 8);
                HG_BAR();
                wait_raw(RC); load_raw(C, RB, t + 4); if (t + 2 < 72) emit_tiles(C, RC, t & 1, t + 2 >= 8);
                HG_BAR();
            }
            drain_raw(RA, RB, RC);
        } else {
            f32x16 S[4];
#pragma unroll
            for (int kb = 0; kb < 4; ++kb)
#pragma unroll
                for (int i = 0; i < 16; ++i) S[kb][i] = 0.f;
            for (int t = 0; t < 75; ++t) {
                if (t >= 1 && t <= 72) consume(C, S, t - 1, (t - 1) & 1);
                HG_BAR();
            }
        }
    }
}
}
#ifndef GEMM_ALIGN
#define GEMM_ALIGN true
#endif
#ifndef GEMM_SP2
#define GEMM_SP2 true
#endif
struct Args { const float* in[16]; float* out; unsigned char* ws; int ph_lo, ph_hi, li, pad; };
__global__ void __launch_bounds__(NWAVES * 64, 2) dit_fwd(Args args) {
    extern __shared__ __attribute__((aligned(16))) unsigned char lds[];
    Frame F;
    F.lds = (LAS unsigned char*)lds;
    F.MISC = (volatile LAS unsigned*)(F.lds + MISC_OFF);
    F.tid = threadIdx.x; F.lane = F.tid & 63; F.wave = __builtin_amdgcn_readfirstlane(F.tid >> 6);
    F.G = gridDim.x; { const int bx = blockIdx.x; F.vcu = (F.G % 8 == 0) ? (bx % 8) * (F.G / 8) + bx / 8 : bx; }
    unsigned char* ws = args.ws; F.ws = ws;
    F.ctl = (gu32*)(ws + WS_CTL);
    F.x = args.in[0]; F.c = args.in[1]; F.ctx = args.in[2]; F.c_ctx = args.in[3]; F.norm_w = args.in[4]; F.w_ada = args.in[5]; F.b_ada = args.in[6]; F.w_in = args.in[7];
    F.q_norm_w = args.in[8]; F.k_norm_w = args.in[9]; F.lb_logits = args.in[10]; F.hg_norm_w = args.in[11]; F.w_proj_hg = args.in[12]; F.w_proj_att = args.in[13]; F.w_out = args.in[14]; F.final_norm_w = args.in[15];
    F.out = args.out;
    for (int u = F.tid; u < (LDS_BYTES - LDSCTL_OFF) / 4; u += NWAVES * 64) ((LAS unsigned*)(F.lds + LDSCTL_OFF))[u] = 0u;
    __syncthreads();
    XcdBarrier bar; bar.bar = (unsigned*)(F.ctl + CW_BAR); bar.x = 0; bar.st = nullptr;
    if (N_LAUNCHES == 1) bar = xcd_barrier_post((unsigned*)(F.ctl + CW_BAR), F.MISC + 8);
#define GRID_BAR(seam) do { if (N_LAUNCHES == 1) { xcd_barrier(bar); } } while (0)
    const int lo = args.ph_lo, hi = args.ph_hi;
#ifndef PH_MASK
#define PH_MASK 0xFFFF
#endif
#define IN(k) (((PH_MASK >> (k)) & 1) && lo <= (k) && (k) < hi)
#define BOTH(k) (IN(k) && IN((k) + 1))

#ifndef DUP_COUNT
#define DUP_COUNT 2
#endif
#ifndef DUP_PHASE
#define DUP_PHASE -1
#endif
#define PHASE_(k, seam, ...) if (IN(k)) { _Pragma("unroll") for (int rep_ = 0; rep_ < ((DUP_PHASE == (k)) ? DUP_COUNT : 1); ++rep_) { __VA_ARGS__; if (((seam) && BOTH(k)) || rep_ + 1 < ((DUP_PHASE == (k)) ? DUP_COUNT : 1)) GRID_BAR(k); } }
#define PHASE(k, ...) PHASE_(k, true, __VA_ARGS__)
#define PHASE_NOSEAM(k, ...) PHASE_(k, N_LAUNCHES != 1, __VA_ARGS__)
    PHASE(0, p0_prologue(F))
    PHASE(1, { p1_modulate(F); p0c_convert(F); })
    PHASE(2, {
        pg8::Gemm g{(const pg8::bf16_t*)(ws + WS_H), (const pg8::bf16_t*)(ws + WS_WIN), MH, NIN, DM}; pg8::InOrder S; S.init(F.G, (int)blockIdx.x);
        pg8::EpiIn E{ws, (const float*)(ws + WS_TAB + TAB_LB)};
        pg8::gemm_phase<pg8::EpiIn, pg8::InOrder, GEMM_ALIGN, GEMM_SP2, true>(F.lds + RING_OFF, g, S, E);
        if (F.G == 256 && ((int)blockIdx.x >> 3) >= 28) p2_tail_convert(F, (((int)blockIdx.x >> 3) - 28) * 8 + ((int)blockIdx.x & 7)); })
    PHASE_NOSEAM(3, hg::phase(F))
    PHASE(4, p3_qk_norm_rope(F))
#ifndef PROBE_KEYS
#define PROBE_KEYS SKV
#endif
    PHASE_NOSEAM(5, p5_attention(F, (DUP_PHASE == 5 && rep_ + 1 < DUP_COUNT) ? PROBE_KEYS : SKV))
    PHASE(6, p6_hgrn_out(F))
    PHASE_NOSEAM(7, {
        pg8::Gemm g{(const pg8::bf16_t*)(ws + WS_YHG), (const pg8::bf16_t*)(ws + WS_WPH), MX, DM, DM}; pg8::StaticOrder S; S.init(MX, DM, F.G, (int)blockIdx.x);
        pg8::EpiProjA E{(const pg8::bf16_t*)(ws + WS_RHG), (float*)(ws + WS_TMP)};
        pg8::gemm_phase<pg8::EpiProjA, pg8::StaticOrder, true, true, true>(F.lds + RING_OFF, g, S, E); })
    PHASE(8, {
        pg8::Gemm g{(const pg8::bf16_t*)(ws + WS_YATT), (const pg8::bf16_t*)(ws + WS_WPA), MX, DM, DM}; pg8::StaticOrder S; S.init(MX, DM, F.G, (int)blockIdx.x);
        pg8::EpiProjB E{(const pg8::bf16_t*)(ws + WS_RATT), (const float*)(ws + WS_TMP), (pg8::bf16_t*)(ws + WS_MRG)};
        pg8::gemm_phase<pg8::EpiProjB, pg8::StaticOrder, true, true, true>(F.lds + RING_OFF, g, S, E); })
    PHASE(9, {
        if (F.G == 256) {
            pg8::Gemm g{(const pg8::bf16_t*)(ws + WS_MRG), (const pg8::bf16_t*)(ws + WS_WO), MX, DM, DM};
            pg8::EpiOutNorm E{F.x, (const float*)(ws + WS_TAB + TAB_GATE), F.final_norm_w, F.out, (unsigned*)(ws + WS_XB), (unsigned*)(F.ctl + CW_PANEL), (unsigned*)F.ctl};
            { pg8::RoundOrder S; S.init(F.vcu, 0); pg8::gemm_phase<pg8::EpiOutNorm, pg8::RoundOrder, false, true, true>(F.lds + RING_OFF, g, S, E); }
            __syncthreads();
            { pg8::RoundOrder S; S.init(F.vcu, 1); pg8::gemm_phase<pg8::EpiOutNorm, pg8::RoundOrder, false, true, true>(F.lds + RING_OFF, g, S, E); }
        } else {
            pg8::Gemm g{(const pg8::bf16_t*)(ws + WS_MRG), (const pg8::bf16_t*)(ws + WS_WO), MX, DM, DM}; pg8::StaticOrder S; S.init(MX, DM, F.G, (int)blockIdx.x);
            pg8::EpiOut E{F.x, (const float*)(ws + WS_TAB + TAB_GATE), F.out};
            pg8::gemm_phase<pg8::EpiOut, pg8::StaticOrder, true, true, true>(F.lds + RING_OFF, g, S, E);
            GRID_BAR(9); p10_final_norm(F);
        } })

#undef PHASE
#undef PHASE_NOSEAM
#undef PHASE_
#undef IN
#undef BOTH
}

extern "C" void kernel_launch(void* const* d_in, const int* in_sizes, int n_in, void* d_out, int out_size, void* d_ws, size_t ws_size, hipStream_t stream) {
    static int grid = 0;
    if (grid == 0) {
        if (n_in != 16 || in_sizes[0] != MX * DM || out_size != MX * DM || ws_size < WS_END) { fprintf(stderr, "kernel_launch: shape mismatch: n_in %d in0 %d out %d ws %zu (need %zu); nothing launched\n", n_in, n_in > 0 ? in_sizes[0] : -1, out_size, ws_size, (size_t)WS_END); grid = -1; return; }
        int dev = 0, cus = 0, per_cu = 0;
        if (hipGetDevice(&dev) != hipSuccess || hipDeviceGetAttribute(&cus, hipDeviceAttributeMultiprocessorCount, dev) != hipSuccess) { fprintf(stderr, "kernel_launch: device query failed\n"); grid = -1; return; }
        if (hipFuncSetAttribute((const void*)dit_fwd, hipFuncAttributeMaxDynamicSharedMemorySize, LDS_BYTES) != hipSuccess) { fprintf(stderr, "kernel_launch: hipFuncSetAttribute failed\n"); grid = -1; return; }
        if (hipOccupancyMaxActiveBlocksPerMultiprocessor(&per_cu, (const void*)dit_fwd, NWAVES * 64, LDS_BYTES) != hipSuccess || per_cu < 1)
            fprintf(stderr, "kernel_launch: note: occupancy query reports %d workgroups per CU\n", per_cu);
        (void)hipGetLastError();
        grid = cus;
    }
    if (grid < 0) return;
    if (hipMemsetAsync((char*)d_ws + WS_CTL, 0, CTL_ZERO_BYTES, stream) != hipSuccess) { fprintf(stderr, "kernel_launch: hipMemsetAsync failed\n"); return; }
    Args a{};
    for (int i = 0; i < 16; ++i) a.in[i] = (const float*)d_in[i];
    a.out = (float*)d_out; a.ws = (unsigned char*)d_ws;
    for (int li = 0; li < N_LAUNCHES; ++li) {
        a.ph_lo = (N_LAUNCHES == 1) ? 0 : li; a.ph_hi = (N_LAUNCHES == 1) ? N_PHASES : li + 1; a.li = li; a.pad = 0;
        hipLaunchKernelGGL(dit_fwd, dim3(grid), dim3(NWAVES * 64), LDS_BYTES, stream, a);
        const hipError_t le = hipPeekAtLastError();
        if (le != hipSuccess) { fprintf(stderr, "kernel_launch: launch %d failed: %s\n", li, hipGetErrorName(le)); break; }
    }
}
```
